# Optimizing an MI355X kernel written in HIP

```python
import math
import jax
import jax.numpy as jnp
from jax import lax
import numpy as np

D_MODEL = 1024
BATCH = 16
SEQ = 2048
DEPTH = 1

HEAD_DIM = 64
N_HEADS_SB = 8
N_HEADS_DIL = 8
D_SB = N_HEADS_SB * HEAD_DIM
D_DIL = N_HEADS_DIL * HEAD_DIM
D_MIX = D_SB + D_DIL
D_FF = 2816
DIL_CONFIGS = ((128, 1), (512, 4), (2048, 16))
BLOCK = 128
N_BUCKETS = 32
MAX_DISTANCE = 2048
N_MOD = 9
EPS = 1e-6
NEG_INF = -1e30

kernel_name = 'hybrid_stickbreak_dilated_macaron_adaln'


def rmsnorm(x, g):
    x32 = x.astype(jnp.float32)
    y = x32 * lax.rsqrt(jnp.mean(x32 * x32, axis=-1, keepdims=True) + EPS)
    return y.astype(x.dtype) * g


def modulate(x, g, shift, scale):
    return rmsnorm(x, g) * (1 + scale[:, None, :]) + shift[:, None, :]


def swiglu(h, w_gate, w_up, w_down):
    return (jax.nn.silu(h @ w_gate) * (h @ w_up)) @ w_down


def to_heads(a, n_heads):
    b, s, _ = a.shape
    return a.reshape(b, s, n_heads, HEAD_DIM).transpose(0, 2, 1, 3)


def from_heads(a):
    b, h, s, d = a.shape
    return a.transpose(0, 2, 1, 3).reshape(b, s, h * d)


def t5_causal_bucket(n):
    max_exact = N_BUCKETS // 2
    nf = np.maximum(n, 1).astype(np.float32)
    large = max_exact + (np.log(nf / max_exact) / math.log(MAX_DISTANCE / max_exact)
                         * (N_BUCKETS - max_exact)).astype(np.int32)
    large = np.minimum(large, N_BUCKETS - 1)
    return np.where(n < max_exact, n, large).astype(np.int32)


def stick_breaking_attention(q, k, v):
    b, h, s, dh = q.shape
    n_blk = s // BLOCK
    scale = dh ** -0.5
    key_pos = jnp.arange(s)

    def one_block(blk):
        qb = lax.dynamic_slice_in_dim(q, blk * BLOCK, BLOCK, axis=2)
        z = jnp.einsum('bhtd,bhsd->bhts', qb, k).astype(jnp.float32) * scale
        q_pos = blk * BLOCK + jnp.arange(BLOCK)
        causal = key_pos[None, :] < q_pos[:, None]
        log_not = jnp.where(causal, jax.nn.log_sigmoid(-z), 0.0)
        suffix = lax.cumsum(log_not, axis=3, reverse=True) - log_not
        w = jnp.where(causal, jnp.exp(jax.nn.log_sigmoid(z) + suffix), 0.0)
        return jnp.einsum('bhts,bhsd->bhtd', w.astype(v.dtype), v)

    out = lax.map(one_block, jnp.arange(n_blk))
    return out.transpose(1, 2, 0, 3, 4).reshape(b, h, s, dh)


def dilated_config(q, k, v, bias_table, window, dilation):
    b, h, s, dh = q.shape
    n_steps = window // dilation
    sub_len = s // dilation
    n_blk = -(-sub_len // BLOCK)
    pad = n_blk * BLOCK - sub_len

    def to_residue(a):
        a = a.reshape(b, h, sub_len, dilation, dh).transpose(0, 1, 3, 2, 4)
        a = jnp.pad(a, ((0, 0), (0, 0), (0, 0), (0, pad), (0, 0)))
        return a.reshape(b, h, dilation, n_blk, BLOCK, dh)

    def with_prev(a):
        prev = jnp.pad(a, ((0, 0), (0, 0), (0, 0), (1, 0), (0, 0), (0, 0)))[:, :, :, :-1]
        return jnp.concatenate([prev, a], axis=4)

    qr = to_residue(q)
    kb = with_prev(to_residue(k))
    vb = with_prev(to_residue(v))
    z = jnp.einsum('bhrnqd,bhrnkd->bhrnqk', qr, kb).astype(jnp.float32) * (dh ** -0.5)

    step = BLOCK + np.arange(BLOCK)[:, None] - np.arange(2 * BLOCK)[None, :]
    in_band = (step >= 0) & (step <= n_steps)
    has_prev = (np.arange(n_blk)[:, None, None] > 0) | (np.arange(2 * BLOCK)[None, None, :] >= BLOCK)
    valid = in_band[None] & has_prev

    bias = bias_table[t5_causal_bucket(np.arange(n_steps + 1) * dilation)]
    bias = bias[np.clip(step, 0, n_steps)].astype(jnp.float32)
    z = z + bias.transpose(2, 0, 1)[None, :, None, None]
    z = jnp.where(valid[None, None, None], z, NEG_INF)

    m = jnp.max(z, axis=-1, keepdims=True)
    e = jnp.exp(z - m)
    denom = jnp.sum(e, axis=-1)
    o = jnp.einsum('bhrnqk,bhrnkd->bhrnqd', e.astype(v.dtype), vb) / denom[..., None].astype(v.dtype)
    lse = m[..., 0] + jnp.log(denom)

    def from_residue(a):
        a = a.reshape(b, h, dilation, n_blk * BLOCK, a.shape[-1])[:, :, :, :sub_len]
        return a.transpose(0, 1, 3, 2, 4).reshape(b, h, s, a.shape[-1])

    return from_residue(o), from_residue(lse[..., None])[..., 0]


def dilated_attention(q, k, v, bias_table):
    outs, lses = [], []
    for window, dilation in DIL_CONFIGS:
        o, lse = dilated_config(q, k, v, bias_table, window, dilation)
        outs.append(o)
        lses.append(lse)
    alpha = jax.nn.softmax(jnp.stack(lses, axis=0), axis=0)
    return jnp.einsum('cbhs,cbhsd->bhsd', alpha.astype(q.dtype), jnp.stack(outs, axis=0))


def token_mixer(h, w_in, g_sb_out, g_dil_out, w_out, rel_bias):
    qkv = h @ w_in
    q_sb, k_sb, v_sb, q_dil, k_dil, v_dil = jnp.split(
        qkv, [D_SB, 2 * D_SB, 3 * D_SB, 3 * D_SB + D_DIL, 3 * D_SB + 2 * D_DIL], axis=-1)
    o_sb = stick_breaking_attention(to_heads(q_sb, N_HEADS_SB), to_heads(k_sb, N_HEADS_SB),
                                    to_heads(v_sb, N_HEADS_SB))
    o_dil = dilated_attention(to_heads(q_dil, N_HEADS_DIL), to_heads(k_dil, N_HEADS_DIL),
                              to_heads(v_dil, N_HEADS_DIL), rel_bias)
    o_sb = rmsnorm(o_sb, g_sb_out[:, None, :])
    o_dil = rmsnorm(o_dil, g_dil_out[:, None, :])
    o = jnp.concatenate([from_heads(o_sb), from_heads(o_dil)], axis=-1)
    return o @ w_out


def setup_inputs(seed: int = 0) -> dict:
    key = jax.random.key(seed)
    ks = jax.random.split(key, 20)
    f32 = jnp.float32

    def nrm(k, shape, scale):
        return jax.random.normal(k, shape, f32) * scale

    def gain(k, shape):
        return 1.0 + 0.05 * jax.random.normal(k, shape, f32)

    L, D = DEPTH, D_MODEL
    return {
        'x': nrm(ks[0], (BATCH, SEQ, D), 1.0),
        'c': nrm(ks[1], (BATCH, D), 1.0),
        'w_ada': nrm(ks[2], (L, D, N_MOD * D), 0.5 * D ** -0.5),
        'b_ada': nrm(ks[3], (L, N_MOD * D), 0.02),
        'g_ffn1': gain(ks[4], (L, D)),
        'w1_gate': nrm(ks[5], (L, D, D_FF), D ** -0.5),
        'w1_up': nrm(ks[6], (L, D, D_FF), D ** -0.5),
        'w1_down': nrm(ks[7], (L, D_FF, D), D_FF ** -0.5),
        'g_mix': gain(ks[8], (L, D)),
        'w_in': nrm(ks[9], (L, D, 3 * D_MIX), D ** -0.5),
        'g_sb_out': gain(ks[10], (L, N_HEADS_SB, HEAD_DIM)),
        'g_dil_out': gain(ks[11], (L, N_HEADS_DIL, HEAD_DIM)),
        'w_out': nrm(ks[12], (L, D_MIX, D), D_MIX ** -0.5),
        'rel_bias': nrm(ks[13], (N_BUCKETS, N_HEADS_DIL), 0.5),
        'g_ffn2': gain(ks[14], (L, D)),
        'w2_gate': nrm(ks[15], (L, D, D_FF), D ** -0.5),
        'w2_up': nrm(ks[16], (L, D, D_FF), D ** -0.5),
        'w2_down': nrm(ks[17], (L, D_FF, D), D_FF ** -0.5),
        'g_final': gain(ks[18], (D,)),
    }


def reference(x, c, w_ada, b_ada, g_ffn1, w1_gate, w1_up, w1_down, g_mix, w_in, g_sb_out,
              g_dil_out, w_out, rel_bias, g_ffn2, w2_gate, w2_up, w2_down, g_final):
    for l in range(DEPTH):
        mod = (jax.nn.silu(c) @ w_ada[l] + b_ada[l]).reshape(c.shape[0], N_MOD, D_MODEL)
        sh1, sc1, gt1, sh2, sc2, gt2, sh3, sc3, gt3 = [mod[:, i] for i in range(N_MOD)]
        h = modulate(x, g_ffn1[l], sh1, sc1)
        x = x + 0.5 * gt1[:, None, :] * swiglu(h, w1_gate[l], w1_up[l], w1_down[l])
        h = modulate(x, g_mix[l], sh2, sc2)
        x = x + gt2[:, None, :] * token_mixer(h, w_in[l], g_sb_out[l], g_dil_out[l], w_out[l], rel_bias)
        h = modulate(x, g_ffn2[l], sh3, sc3)
        x = x + 0.5 * gt3[:, None, :] * swiglu(h, w2_gate[l], w2_up[l], w2_down[l])
    return rmsnorm(x, g_final)
```

```cpp
#include <hip/hip_runtime.h>
#include <cstdio>
#include <cstdint>
namespace pg8 {
#define PG8_LAS __attribute__((address_space(3)))
typedef unsigned short bf16_t;
typedef short bf16x8 __attribute__((ext_vector_type(8)));
typedef float f32x4 __attribute__((ext_vector_type(4)));
typedef unsigned u32x4 __attribute__((ext_vector_type(4)));
constexpr int BM = 256, BK = 64, HALF = 128, HTB = HALF * BK * 2  , STAGE_BYTES = 8 * HTB, NXCD = 8, WGM = 8;

__host__ __device__ __forceinline__ int lds_byte(int r, int c) { const int st = (r >> 4) * 2 + (c >> 5), rr = r & 15, cc = c & 31, ob = rr * 64 + cc * 2; return st * 1024 + (ob ^ (((ob >> 9) & 1) << 5)); }
__host__ __device__ __forceinline__ void stage_rc(int b, int& R, int& C) { const int st = b / 1024, sb = b % 1024, swz = sb ^ (((sb >> 9) & 1) << 5); R = (st >> 1) * 16 + swz / 64; C = (st & 1) * 32 + (swz % 64) / 2; }
__host__ __device__ __forceinline__ int perm32(int rho) { const int n = rho >> 4, i = rho & 15; return 8 * (i >> 2) + 4 * n + (i & 3); }

struct Unit { int pm, pn; };
struct Gemm { const bf16_t* A; const bf16_t* Bt; int M, N, K; };

struct StaticOrder {
    int nM, nN, nwg, G, c;
    __host__ __device__ void init(int M, int N, int G_, int c_) { nM = M / BM; nN = N / BM; nwg = nM * nN; G = G_; c = c_; }
    __host__ __device__ bool next(int i, Unit& u) const {
        const long L = (long)i * G + c; if (L >= nwg) return false;
        int wgid = (int)L; { const int q = nwg / NXCD, r = nwg % NXCD, xcd = wgid % NXCD, off = wgid / NXCD; wgid = (xcd < r ? xcd * (q + 1) : r * (q + 1) + (xcd - r) * q) + off; }
        const int nig = WGM * nN, gid = wgid / nig, fm = gid * WGM, gsz = (nM - fm) < WGM ? (nM - fm) : WGM;
        u.pm = fm + ((wgid % nig) % gsz); u.pn = (wgid % nig) / gsz; return true;
    }
    __device__ __forceinline__ void a_ready(const Unit&) const {}
    __device__ __forceinline__ void done(const Unit&) const {}
};


typedef float f32x2_t __attribute__((ext_vector_type(2))); typedef __bf16 bf16x2_t __attribute__((ext_vector_type(2)));
typedef unsigned u32x2 __attribute__((ext_vector_type(2)));
__device__ __forceinline__ unsigned cvtpk(float lo, float hi) { f32x2_t v = {lo, hi}; bf16x2_t b = __builtin_convertvector(v, bf16x2_t); return __builtin_bit_cast(unsigned, b); }
constexpr float RMS_EPS = 1e-6f, LOG2E = 1.4426950408889634f;
__device__ __forceinline__ float silu1(float x) { return x * __builtin_amdgcn_rcpf(1.0f + __builtin_amdgcn_exp2f(-LOG2E * x)); }
__device__ __forceinline__ f32x4 silu4(f32x4 v) { f32x4 o; o.x = silu1(v.x); o.y = silu1(v.y); o.z = silu1(v.z); o.w = silu1(v.w); return o; }

struct EpiSwiGLU {
    static constexpr bool PERM = true, AFTER_DRAIN = false;
    bf16_t* H; const float* rowss; const float* bias;
    __device__ __forceinline__ void operator()(const f32x4 (&acc)[2][2][4][2], const Unit& u, int wr, int wc, int fr, int fq) const {
        const int row0 = u.pm * BM + wr * 64 + fr, b = u.pm >> 3;
        const int hc = u.pn * 128 + wc * 32 + 8 * fq;
        const float* bp = bias + (size_t)b * 5632 + u.pn * 256 + wc * 32 + 8 * fq;
        const f32x4 bg0 = *(const f32x4*)(bp), bg1 = *(const f32x4*)(bp + 4), bu0 = *(const f32x4*)(bp + 128), bu1 = *(const f32x4*)(bp + 132);
#pragma unroll
        for (int ai = 0; ai < 2; ++ai)
#pragma unroll
            for (int m = 0; m < 4; ++m) {
                const int r = row0 + ai * HALF + m * 16;
                const float rs = __builtin_amdgcn_rsqf(rowss[r] * (1.0f / 1024.0f) + RMS_EPS);
                const f32x4 g0 = acc[ai][0][m][0] * rs + bg0, g1 = acc[ai][0][m][1] * rs + bg1, u0 = acc[ai][1][m][0] * rs + bu0, u1 = acc[ai][1][m][1] * rs + bu1;
                const f32x4 h0 = silu4(g0) * u0, h1 = silu4(g1) * u1;
                u32x4 w; w.x = cvtpk(h0[0], h0[1]); w.y = cvtpk(h0[2], h0[3]); w.z = cvtpk(h1[0], h1[1]); w.w = cvtpk(h1[2], h1[3]);
                *(u32x4*)(H + (size_t)r * 2816 + hc) = w;
            }
    }
};
struct EpiQKV {
    static constexpr bool PERM = true, AFTER_DRAIN = false;
    bf16_t* O; const float* rowss; const float* bias;
    __device__ __forceinline__ void operator()(const f32x4 (&acc)[2][2][4][2], const Unit& u, int wr, int wc, int fr, int fq) const {
        const int row0 = u.pm * BM + wr * 64 + fr, b = u.pm >> 3;
        const int c0 = u.pn * BM + wc * 32 + 8 * fq;
        const float sc = (u.pn < 2 || u.pn == 6 || u.pn == 7) ? (0.125f * LOG2E) : 1.0f;
        const float* bp = bias + (size_t)b * 3072 + c0;
        f32x4 bv[2][2];
#pragma unroll
        for (int bj = 0; bj < 2; ++bj)
#pragma unroll
            for (int n = 0; n < 2; ++n) bv[bj][n] = *(const f32x4*)(bp + bj * HALF + 4 * n);
#pragma unroll
        for (int ai = 0; ai < 2; ++ai)
#pragma unroll
            for (int m = 0; m < 4; ++m) {
                const int r = row0 + ai * HALF + m * 16;
                const float rs = __builtin_amdgcn_rsqf(rowss[r] * (1.0f / 1024.0f) + RMS_EPS);
                bf16_t* rowp = O + (size_t)r * 3072 + c0;
#pragma unroll
                for (int bj = 0; bj < 2; ++bj) {
                    const f32x4 v0 = (acc[ai][bj][m][0] * rs + bv[bj][0]) * sc, v1 = (acc[ai][bj][m][1] * rs + bv[bj][1]) * sc;
                    u32x4 w; w.x = cvtpk(v0[0], v0[1]); w.y = cvtpk(v0[2], v0[3]); w.z = cvtpk(v1[0], v1[1]); w.w = cvtpk(v1[2], v1[3]);
                    *(u32x4*)(rowp + bj * HALF) = w;
                }
            }
    }
};
template <bool WRITE_XA> struct EpiResid {
    static constexpr bool PERM = false, AFTER_DRAIN = false;
    const float* base; float* out; bf16_t* xa; const float* gv; const float* av; float* rowss;
    __device__ __forceinline__ void operator()(const f32x4 (&acc)[2][2][4][2], const Unit& u, int wr, int wc, int fr, int fq) const {
        const int row0 = u.pm * BM + wr * 64 + fr, b = u.pm >> 3;
        const int c0 = u.pn * BM + wc * 32 + 4 * fq;
        f32x4 g[2][2], a[2][2];
#pragma unroll
        for (int bj = 0; bj < 2; ++bj)
#pragma unroll
            for (int n = 0; n < 2; ++n) { g[bj][n] = *(const f32x4*)(gv + (size_t)b * 1024 + c0 + bj * HALF + n * 16);
                if (WRITE_XA) a[bj][n] = *(const f32x4*)(av + (size_t)b * 1024 + c0 + bj * HALF + n * 16); }
#pragma unroll
        for (int ai = 0; ai < 2; ++ai)
#pragma unroll
            for (int m = 0; m < 4; ++m) {
                const int r = row0 + ai * HALF + m * 16; const size_t off = (size_t)r * 1024 + c0; float ss = 0.f;
#pragma unroll
                for (int bj = 0; bj < 2; ++bj)
#pragma unroll
                    for (int n = 0; n < 2; ++n) {
                        const f32x4 x = *(const f32x4*)(base + off + bj * HALF + n * 16);
                        const f32x4 xn = x + g[bj][n] * acc[ai][bj][m][n];
                        *(f32x4*)(out + off + bj * HALF + n * 16) = xn;
                        ss += (xn[0] * xn[0] + xn[1] * xn[1]) + (xn[2] * xn[2] + xn[3] * xn[3]);
                        if (WRITE_XA) { const f32x4 y = xn * a[bj][n]; u32x2 w; w.x = cvtpk(y[0], y[1]); w.y = cvtpk(y[2], y[3]); *(u32x2*)(xa + off + bj * HALF + n * 16) = w; }
                    }
                ss += __shfl_xor(ss, 16); ss += __shfl_xor(ss, 32);
                if (fq == 0) atomicAdd(rowss + r, ss);
                asm volatile("" ::: "memory");
            }
    }
};
template <class Epi, class Sched, bool ALIGN_EPI = false, bool SP2 = false>
__device__ __forceinline__ void gemm_phase(PG8_LAS unsigned char* lds, const Gemm g, const Sched& S, const Epi& E) {
    const int tid = threadIdx.x, wid = __builtin_amdgcn_readfirstlane(tid >> 6), lane = tid & 63, wr = wid >> 2, wc = wid & 3, fr = lane & 15, fq = lane >> 4;
    const int K = g.K, nt = K / BK;
    unsigned voffA[2], voffB[2];
#pragma unroll
    for (int i = 0; i < 2; ++i) { int R, C; stage_rc(tid * 16 + i * 8192, R, C); const int Rb = Epi::PERM ? ((R & ~31) + perm32(R & 31)) : R;
        voffA[i] = (unsigned)(R * K + C) * 2u; voffB[i] = (unsigned)(Rb * K + C) * 2u; }
    const size_t kstep = (size_t)(BK * 2);
    const size_t hstep = (size_t)HALF * K * 2;
    const size_t tstep = 2 * hstep;
    const unsigned ldsw = (unsigned)wid * 1024u;
    const int aoff = lds_byte(wr * 64 + fr, fq * 8), boff = lds_byte(wc * 32 + fr, fq * 8);
#define PG8_SA(b, h) (((b) * 2 + (h)) * HTB)
#define PG8_SB(b, h) ((4 + (b) * 2 + (h)) * HTB)
#define PG8_STAGE(bufoff, gbase, voff) do { _Pragma("unroll") for (int _i = 0; _i < 2; ++_i) \
        __builtin_amdgcn_global_load_lds((const unsigned*)((const char*)(gbase) + (voff)[_i]), (PG8_LAS unsigned*)(lds + (bufoff) + ldsw + _i * 8192), 16, 0, 0); } while (0)
#define PG8_LDA(dst, b, h) do { _Pragma("unroll") for (int m = 0; m < 4; ++m) _Pragma("unroll") for (int k = 0; k < 2; ++k) dst[m][k] = *(const PG8_LAS bf16x8*)(lds + PG8_SA(b, h) + aoff + m * 2048 + k * 1024); } while (0)
#define PG8_LDB(dst, b, h) do { _Pragma("unroll") for (int n = 0; n < 2; ++n) _Pragma("unroll") for (int k = 0; k < 2; ++k) dst[n][k] = *(const PG8_LAS bf16x8*)(lds + PG8_SB(b, h) + boff + n * 2048 + k * 1024); } while (0)
#define PG8_MMA(ai, bj, At, Bt) do { __builtin_amdgcn_s_setprio(1); _Pragma("unroll") for (int m = 0; m < 4; ++m) _Pragma("unroll") for (int n = 0; n < 2; ++n) _Pragma("unroll") for (int k = 0; k < 2; ++k) \
        acc[ai][bj][m][n] = __builtin_amdgcn_mfma_f32_16x16x32_bf16(Bt[n][k], At[m][k], acc[ai][bj][m][n], 0, 0, 0); __builtin_amdgcn_s_setprio(0); } while (0)
#define PG8_WAIT_V(n) asm volatile("s_waitcnt vmcnt(" #n ")" ::: "memory")
#define PG8_WAIT_L(n) asm volatile("s_waitcnt lgkmcnt(" #n ")" ::: "memory")
#define PG8_BAR __builtin_amdgcn_s_barrier()
#define PG8_SCHED __builtin_amdgcn_sched_barrier(0)
    Unit cur, nxt; int ui = 0;
    if (!S.next(0, cur)) return;
    f32x4 acc[2][2][4][2];
#pragma unroll
    for (int a = 0; a < 2; ++a)
#pragma unroll
        for (int b = 0; b < 2; ++b)
#pragma unroll
            for (int m = 0; m < 4; ++m)
#pragma unroll
                for (int n = 0; n < 2; ++n) acc[a][b][m][n] = (f32x4){0.f, 0.f, 0.f, 0.f};
    bf16x8 At[4][2], B0[2][2], B1[2][2];
    const char* cA = (const char*)g.A + (size_t)cur.pm * tstep; const char* cB = (const char*)g.Bt + (size_t)cur.pn * tstep;
    S.a_ready(cur);
    if constexpr (SP2) {
        PG8_STAGE(PG8_SB(0, 0), cB, voffB); PG8_STAGE(PG8_SB(0, 1), cB + hstep, voffB); PG8_STAGE(PG8_SA(0, 0), cA, voffA); PG8_STAGE(PG8_SA(0, 1), cA + hstep, voffA);
        if (wr == 1) PG8_BAR;
        PG8_WAIT_V(2); PG8_BAR;
        PG8_STAGE(PG8_SB(1, 0), cB + kstep, voffB); PG8_STAGE(PG8_SA(1, 0), cA + kstep, voffA); PG8_STAGE(PG8_SB(1, 1), cB + hstep + kstep, voffB);
        PG8_WAIT_V(6); PG8_BAR;
    } else {
        PG8_STAGE(PG8_SB(0, 0), cB, voffB); PG8_STAGE(PG8_SA(0, 0), cA, voffA); PG8_STAGE(PG8_SB(0, 1), cB + hstep, voffB); PG8_STAGE(PG8_SA(0, 1), cA + hstep, voffA);
        if (wr == 1) PG8_BAR;
        PG8_WAIT_V(4); PG8_BAR;
        PG8_STAGE(PG8_SB(1, 0), cB + kstep, voffB); PG8_STAGE(PG8_SA(1, 0), cA + kstep, voffA); PG8_STAGE(PG8_SB(1, 1), cB + hstep + kstep, voffB);
        PG8_WAIT_V(6); PG8_BAR;
    }
    for (;;) {
        const bool has_next = S.next(ui + 1, nxt);
        const char* nA = has_next ? (const char*)g.A + (size_t)nxt.pm * tstep : cA; const char* nB = has_next ? (const char*)g.Bt + (size_t)nxt.pn * tstep : cB;
        for (int t = 0; t < nt; t += 2) {
            const bool last = (t == nt - 2);
            const char* a1 = cA + (size_t)(t + 1) * kstep;
            const char* a2 = last ? nA : cA + (size_t)(t + 2) * kstep; const char* b2 = last ? nB : cB + (size_t)(t + 2) * kstep;
            const char* a3 = a2 + kstep; const char* b3 = b2 + kstep;
            if (last && has_next) S.a_ready(nxt);
            if constexpr (SP2) {
            PG8_LDB(B0, 0, 0); PG8_LDB(B1, 0, 1); PG8_SCHED; PG8_LDA(At, 0, 0); PG8_STAGE(PG8_SA(1, 1), a1 + hstep, voffA);
            PG8_WAIT_V(8); PG8_WAIT_L(0); PG8_BAR; PG8_MMA(0, 0, At, B0); PG8_MMA(0, 1, At, B1); PG8_BAR; PG8_SCHED;
            PG8_LDA(At, 0, 1); PG8_STAGE(PG8_SB(0, 0), b2, voffB); PG8_STAGE(PG8_SB(0, 1), b2 + hstep, voffB); PG8_STAGE(PG8_SA(0, 0), a2, voffA);
            PG8_WAIT_V(8); PG8_WAIT_L(0); PG8_BAR; PG8_MMA(1, 0, At, B0); PG8_MMA(1, 1, At, B1); PG8_BAR; PG8_SCHED;
            PG8_LDB(B0, 1, 0); PG8_LDB(B1, 1, 1); PG8_SCHED; PG8_LDA(At, 1, 0); PG8_STAGE(PG8_SA(0, 1), a2 + hstep, voffA);
            PG8_WAIT_V(8); PG8_WAIT_L(0); PG8_BAR; PG8_MMA(0, 0, At, B0); PG8_MMA(0, 1, At, B1); PG8_BAR; PG8_SCHED;
            PG8_LDA(At, 1, 1); PG8_STAGE(PG8_SB(1, 0), b3, voffB); PG8_STAGE(PG8_SB(1, 1), b3 + hstep, voffB); PG8_STAGE(PG8_SA(1, 0), a3, voffA);
            PG8_WAIT_V(8); PG8_WAIT_L(0); PG8_BAR; PG8_MMA(1, 0, At, B0); PG8_MMA(1, 1, At, B1); PG8_BAR; PG8_SCHED;
            } else {
            PG8_LDB(B0, 0, 0); PG8_SCHED; PG8_LDA(At, 0, 0); PG8_STAGE(PG8_SA(1, 1), a1 + hstep, voffA);
            PG8_WAIT_L(8); PG8_BAR; PG8_WAIT_L(0); PG8_MMA(0, 0, At, B0); PG8_BAR; PG8_SCHED;
            PG8_LDB(B1, 0, 1); PG8_STAGE(PG8_SB(0, 0), b2, voffB);
            PG8_BAR; PG8_WAIT_L(0); PG8_MMA(0, 1, At, B1); PG8_BAR;
            PG8_LDA(At, 0, 1); PG8_STAGE(PG8_SA(0, 0), a2, voffA);
            PG8_BAR; PG8_WAIT_L(0); PG8_MMA(1, 0, At, B0); PG8_BAR; PG8_SCHED;
            PG8_STAGE(PG8_SB(0, 1), b2 + hstep, voffB);
            PG8_WAIT_V(6); PG8_BAR; PG8_MMA(1, 1, At, B1); PG8_BAR;
            PG8_LDB(B0, 1, 0); PG8_SCHED; PG8_LDA(At, 1, 0); PG8_STAGE(PG8_SA(0, 1), a2 + hstep, voffA);
            PG8_WAIT_L(8); PG8_BAR; PG8_WAIT_L(0); PG8_MMA(0, 0, At, B0); PG8_BAR; PG8_SCHED;
            PG8_LDB(B1, 1, 1); PG8_STAGE(PG8_SB(1, 0), b3, voffB);
            PG8_BAR; PG8_WAIT_L(0); PG8_MMA(0, 1, At, B1); PG8_BAR;
            PG8_LDA(At, 1, 1); PG8_STAGE(PG8_SA(1, 0), a3, voffA);
            PG8_BAR; PG8_WAIT_L(0); PG8_MMA(1, 0, At, B0); PG8_BAR; PG8_SCHED;
            PG8_STAGE(PG8_SB(1, 1), b3 + hstep, voffB);
            PG8_WAIT_V(6); PG8_BAR; PG8_MMA(1, 1, At, B1); PG8_BAR;
            }
        }
        if constexpr (ALIGN_EPI) { if (wr == 0) PG8_BAR; }
        if constexpr (!Epi::AFTER_DRAIN) { E(acc, cur, wr, wc, fr, fq); S.done(cur); }
        if (!has_next) break;
#pragma unroll
        for (int a = 0; a < 2; ++a)
#pragma unroll
            for (int b = 0; b < 2; ++b)
#pragma unroll
                for (int m = 0; m < 4; ++m)
#pragma unroll
                    for (int n = 0; n < 2; ++n) acc[a][b][m][n] = (f32x4){0.f, 0.f, 0.f, 0.f};
        cur = nxt; cA = nA; cB = nB; ++ui;
        if constexpr (ALIGN_EPI) { if (wr == 1) PG8_BAR; }
    }
    PG8_WAIT_V(0);
    if constexpr (!ALIGN_EPI) { if (wr == 0) PG8_BAR; }
    PG8_BAR;
    if constexpr (Epi::AFTER_DRAIN) { E.fused(acc, cur, wr, wc, fr, fq, lds, wid, lane); S.done(cur); }
#undef PG8_SA
#undef PG8_SB
#undef PG8_STAGE
#undef PG8_LDA
#undef PG8_LDB
#undef PG8_MMA
#undef PG8_WAIT_V
#undef PG8_WAIT_L
#undef PG8_BAR
#undef PG8_SCHED
}
}

#ifndef PG8_SP2
#define PG8_SP2 true
#endif
#ifndef PG8_ALIGN
#define PG8_ALIGN true
#endif
constexpr int NWAVES = 8;
#ifndef MK_N_LAUNCHES
#define MK_N_LAUNCHES 1
#endif
constexpr int N_PHASES = 11;
constexpr int N_LAUNCHES = MK_N_LAUNCHES;
#ifndef SB_EXIT_THR
#define SB_EXIT_THR 64.0f
#endif

constexpr int BATCH = 16, SEQ = 2048, D = 1024, FF = 2816, NGU = 2 * FF, NQKV = 3072, NMOD = 9, HD = 64, NH = 8;
constexpr int M = BATCH * SEQ;
constexpr float RMS_EPS = 1e-6f, LOG2E = 1.4426950408889634f;

constexpr size_t MiB = 1u << 20;
constexpr size_t WS_CTL = 0, CTL_ZERO_BYTES = 2 * MiB;
constexpr size_t WS_ROWSS = 1 * MiB;
constexpr size_t WS_MOD = 2 * MiB;
constexpr size_t WS_VEC = 3 * MiB;
constexpr size_t WS_BIAS = 4 * MiB;
constexpr size_t WS_ROWSS1 = 5 * MiB;
constexpr size_t WS_W1GU = 6 * MiB, WS_W1D = 17 * MiB, WS_WIN = 23 * MiB, WS_WOUT = 29 * MiB, WS_W2GU = 31 * MiB, WS_W2D = 42 * MiB;
constexpr size_t WS_XA = 48 * MiB;
constexpr size_t WS_O = 112 * MiB;
constexpr size_t WS_HID = 176 * MiB;
constexpr size_t WS_QKV = 176 * MiB;
constexpr size_t WS_PC = 368 * MiB;
constexpr size_t WS_ML = 464 * MiB;
constexpr size_t WS_END = 470 * MiB;
static_assert(WS_W1GU + (size_t)NGU * D * 2 <= WS_W1D && WS_W1D + (size_t)D * FF * 2 <= WS_WIN && WS_WIN + (size_t)NQKV * D * 2 <= WS_WOUT && WS_WOUT + (size_t)D * D * 2 <= WS_W2GU &&
              WS_W2GU + (size_t)NGU * D * 2 <= WS_W2D && WS_W2D + (size_t)D * FF * 2 <= WS_XA && WS_XA + (size_t)M * D * 2 <= WS_O && WS_O + (size_t)M * D * 2 <= WS_HID &&
              WS_HID + (size_t)M * FF * 2 <= WS_PC && WS_QKV + (size_t)M * NQKV * 2 <= WS_PC && WS_PC + (size_t)3 * M * 512 * 2 <= WS_ML && WS_ML + (size_t)3 * M * 8 * 2 * 4 <= WS_END, "d_ws map");
constexpr int CW_TMO = 0, CW_CODE = 1;
constexpr int CW_BAR = 4096;

constexpr int RING_OFF = 0, RING_BYTES = 131072;
constexpr int LDSCTL_OFF = RING_BYTES, MISC_OFF = LDSCTL_OFF + 320;
constexpr int LDS_BYTES = 147456;
static_assert(MISC_OFF + 128 <= LDS_BYTES, "LDS map");

#define GAS __attribute__((address_space(1)))
#define LAS __attribute__((address_space(3)))
typedef unsigned short bf16;
typedef unsigned v4u __attribute__((ext_vector_type(4)));
typedef unsigned v2u __attribute__((ext_vector_type(2)));
typedef float f32x4 __attribute__((ext_vector_type(4)));
typedef float f32x2 __attribute__((ext_vector_type(2)));
typedef float f32x16 __attribute__((ext_vector_type(16)));
typedef short bf16x8 __attribute__((ext_vector_type(8)));
typedef short s16x4 __attribute__((ext_vector_type(4)));
typedef GAS unsigned gu32;
#define RLX_AGENT __ATOMIC_RELAXED, __HIP_MEMORY_SCOPE_AGENT
#define LDS_WAIT() asm volatile("s_waitcnt lgkmcnt(0)" ::: "memory")
#define VM_WAIT() asm volatile("s_waitcnt vmcnt(0)" ::: "memory")
using pg8::cvtpk;
__device__ __forceinline__ float bf2f(unsigned short h) { return __uint_as_float((unsigned)h << 16); }

#define XB_TMO      128
#define XB_XCNT(j)  (256  + 64 * (j))
#define XB_XSUB(j)  (1280 + 64 * (j))
#define XB_XGEN(j)  (2304 + 64 * (j))
#define XB_TOP      3328
#define XB_TOPGEN   3392
#define XCD_BAR_WORDS 3456
#define XB_SPIN_CAP (1u << 18)

__device__ __forceinline__ unsigned xb_ld(unsigned* p)              { return __hip_atomic_load(p, __ATOMIC_RELAXED, __HIP_MEMORY_SCOPE_AGENT); }
__device__ __forceinline__ unsigned xb_add(unsigned* p, unsigned v) { return __hip_atomic_fetch_add(p, v, __ATOMIC_RELAXED, __HIP_MEMORY_SCOPE_AGENT); }
__device__ __forceinline__ unsigned xb_xcc_id() { return (unsigned)__builtin_amdgcn_s_getreg((3 << 11) | 20) & 0xFu; }
#define XB_SPIN(cond, bar) do { unsigned _sp = 0; while (cond) { __builtin_amdgcn_s_sleep(1); \
    if ((++_sp & 255u) == 0u) { if (xb_ld(&(bar)[XB_TMO])) break; if (_sp > XB_SPIN_CAP) { atomicAdd(&(bar)[XB_TMO], 1u); break; } } } } while (0)

struct XcdBarrier {
    unsigned* bar; unsigned x;
    volatile LAS unsigned* st;
};

__device__ __forceinline__ XcdBarrier xcd_barrier_post(unsigned* bar, volatile LAS unsigned* st) {
    XcdBarrier b; b.bar = bar; b.x = xb_xcc_id(); b.st = st;
    if (threadIdx.x == 0) (void)xb_add(&bar[XB_XCNT(b.x)], 1u);
    return b;
}
__device__ __forceinline__ void xcd_barrier_complete(unsigned* bar, unsigned x, unsigned& nloc, unsigned& nx) {
    const unsigned G = gridDim.x * gridDim.y * gridDim.z;
    unsigned sum, cnt, mine, sp = 0u;
    for (;;) {
        sum = 0u; cnt = 0u; mine = 0u;
#pragma unroll
        for (unsigned j = 0; j < 16; ++j) { const unsigned c = xb_ld(&bar[XB_XCNT(j)]); sum += c; cnt += (c > 0u) ? 1u : 0u; mine = (j == x) ? c : mine; }
        if (sum == G) break;
        __builtin_amdgcn_s_sleep(1);
        if ((++sp & 255u) == 0u) { if (xb_ld(&bar[XB_TMO])) break; if (sp > XB_SPIN_CAP) { atomicAdd(&bar[XB_TMO], 1u); break; } }
    }
    nloc = mine > 0u ? mine : 1u; nx = cnt > 0u ? cnt : 1u;
}

__device__ __forceinline__ void xcd_barrier(const XcdBarrier& b) {
    asm volatile("s_waitcnt vmcnt(0)" ::: "memory");
    __syncthreads();
    if (threadIdx.x == 0) {
        unsigned* bar = b.bar;
        __builtin_amdgcn_s_waitcnt(0);
        unsigned nloc = b.st[0], nx = b.st[1];
        if (nloc == 0u) { xcd_barrier_complete(bar, b.x, nloc, nx); b.st[0] = nloc; b.st[1] = nx; }
        const unsigned old = xb_add(&bar[XB_XSUB(b.x)], 1u);
        const unsigned gen = old / nloc;
        if (old + 1u == (gen + 1u) * nloc) {
            __builtin_amdgcn_fence(__ATOMIC_RELEASE, "agent");
            asm volatile("s_waitcnt vmcnt(0)" ::: "memory");
            const unsigned og = xb_add(&bar[XB_TOP], 1u);
            const unsigned tg = og / nx;
            if (og + 1u == (tg + 1u) * nx) xb_add(&bar[XB_TOPGEN], 1u);
            else XB_SPIN(xb_ld(&bar[XB_TOPGEN]) == tg, bar);
            __builtin_amdgcn_fence(__ATOMIC_ACQUIRE, "agent");
            xb_add(&bar[XB_XGEN(b.x)], 1u);
            asm volatile("s_waitcnt vmcnt(0)" ::: "memory");
        } else {
            XB_SPIN(xb_ld(&bar[XB_XGEN(b.x)]) == gen, bar);
            __builtin_amdgcn_fence(__ATOMIC_ACQUIRE, "agent");
            asm volatile("s_waitcnt vmcnt(0)" ::: "memory");
        }
    }
    __syncthreads();
}

struct Frame {
    LAS unsigned char* lds;
    volatile LAS unsigned* MISC;
    gu32* ctl;
    int tid, lane, wave;
    int vcu, G;
};
__device__ __forceinline__ float wave_sum(float v) {
#pragma unroll
    for (int o = 1; o < 64; o <<= 1) v += __shfl_xor(v, o);
    return v;
}
__device__ const unsigned char BKT[3][132] = {
 {0,1,2,3,4,5,6,7,8,9,10,11,12,13,14,15,16,16,16,16,16,16,17,17,17,17,17,17,17,17,18,18,18,18,18,18,18,18,18,18,19,19,19,19,19,19,19,19,19,19,19,19,19,19,20,20,20,20,20,20,20,20,20,20,20,20,20,20,20,20,20,20,20,21,21,21,21,21,21,21,21,21,21,21,21,21,21,21,21,21,21,21,21,21,21,21,21,21,21,22,22,22,22,22,22,22,22,22,22,22,22,22,22,22,22,22,22,22,22,22,22,22,22,22,22,22,22,22,22,0,0,0},
 {0,4,8,12,16,16,17,17,18,18,19,19,19,19,20,20,20,20,20,21,21,21,21,21,21,22,22,22,22,22,22,22,22,22,23,23,23,23,23,23,23,23,23,23,23,23,24,24,24,24,24,24,24,24,24,24,24,24,24,24,24,24,25,25,25,25,25,25,25,25,25,25,25,25,25,25,25,25,25,25,25,25,25,26,26,26,26,26,26,26,26,26,26,26,26,26,26,26,26,26,26,26,26,26,26,26,26,26,26,26,26,26,26,27,27,27,27,27,27,27,27,27,27,27,27,27,27,27,27,0,0,0},
 {0,16,18,19,20,21,21,22,22,23,23,23,24,24,24,24,25,25,25,25,25,26,26,26,26,26,26,26,26,27,27,27,27,27,27,27,27,27,27,28,28,28,28,28,28,28,28,28,28,28,28,28,29,29,29,29,29,29,29,29,29,29,29,29,29,29,29,29,29,29,30,30,30,30,30,30,30,30,30,30,30,30,30,30,30,30,30,30,30,30,30,30,30,30,30,31,31,31,31,31,31,31,31,31,31,31,31,31,31,31,31,31,31,31,31,31,31,31,31,31,31,31,31,31,31,31,31,31,31,0,0,0}};

__device__ __forceinline__ void p0_transpose_item(const float* W, int K, int N, bf16* WT, int k0, int n0, int drow0, LAS float* scr, int lane) {
#pragma unroll 8
    for (int i = 0; i < 32; ++i) { const int kk = 2 * i + (lane >> 5); scr[kk * 33 + (lane & 31)] = W[(size_t)(k0 + kk) * N + n0 + (lane & 31)]; }
    LDS_WAIT(); asm volatile("" ::: "memory");
    const int c = lane & 7;
#pragma unroll
    for (int j = 0; j < 4; ++j) { const int n = (lane >> 3) + 8 * j; const LAS float* s = scr + (8 * c) * 33 + n;
        v4u o; o.x = cvtpk(s[0 * 33], s[1 * 33]); o.y = cvtpk(s[2 * 33], s[3 * 33]); o.z = cvtpk(s[4 * 33], s[5 * 33]); o.w = cvtpk(s[6 * 33], s[7 * 33]);
        *(GAS v4u*)(WT + (size_t)(drow0 + n) * K + k0 + 8 * c) = o; }
    LDS_WAIT(); asm volatile("" ::: "memory");
}
__device__ __forceinline__ bool p0_matrix(int& r, const float* W, int K, int N, bf16* WT, int GU, LAS float* scr, int lane) {
    const int nblk = N / 32, items = (K / 64) * nblk;
    if (r >= items) { r -= items; return false; }
    const int kb = r / nblk, nb = r % nblk, n0 = 32 * nb;
    const int drow0 = GU == 0 ? n0 : ((n0 >> 7) * 256 + (n0 & 127) + (GU == 2 ? 128 : 0));
    p0_transpose_item(W, K, N, WT, 64 * kb, n0, drow0, scr, lane);
    return true;
}
__device__ __forceinline__ void gemv16_unit(LAS unsigned char* lds, const float* W, int N, int col0, const float* S, int s_stride, bool do_silu, float* out, int out_stride, int oc0, const float* addb,
                                            int tid, int wave, int lane) {
    LAS float* Sl = (LAS float*)lds; LAS float* red = (LAS float*)(lds + 65536);
    for (int i = tid; i < 16 * 256; i += NWAVES * 64) { const int b = i >> 8, k4 = (i & 255) * 4; f32x4 v = *(const f32x4*)(S + (size_t)b * s_stride + k4); if (do_silu) v = pg8::silu4(v); *(LAS f32x4*)(Sl + b * 1024 + k4) = v; }
    __syncthreads();
    float acc[16];
#pragma unroll
    for (int b = 0; b < 16; ++b) acc[b] = 0.f;
    const float* wp = W + (size_t)(wave * 128) * N + col0 + lane;
    for (int k = 0; k < 128; k += 4) {
        const float w0 = wp[(size_t)(k + 0) * N], w1 = wp[(size_t)(k + 1) * N], w2 = wp[(size_t)(k + 2) * N], w3 = wp[(size_t)(k + 3) * N];
#pragma unroll
        for (int b = 0; b < 16; ++b) { const f32x4 s = *(const LAS f32x4*)(Sl + b * 1024 + wave * 128 + k); acc[b] += (s.x * w0 + s.y * w1) + (s.z * w2 + s.w * w3); }
    }
#pragma unroll
    for (int b = 0; b < 16; ++b) red[(wave * 16 + b) * 64 + lane] = acc[b];
    __syncthreads();
#pragma unroll
    for (int j = 0; j < 2; ++j) { const int b = 2 * wave + j; float s = 0.f;
#pragma unroll
        for (int w = 0; w < 8; ++w) s += red[(w * 16 + b) * 64 + lane];
        if (addb) s += addb[col0 + lane];
        out[(size_t)b * out_stride + oc0 + lane] = s; }
    __syncthreads();
}

typedef LAS const char* lds_cptr;
typedef short v4i16_t __attribute__((ext_vector_type(4)));
__device__ __forceinline__ s16x4 vtr(lds_cptr p) { return __builtin_bit_cast(s16x4, __builtin_amdgcn_ds_read_tr16_b64_v4i16((LAS v4i16_t*)p)); }
#define MFMA32(a, b, c) __builtin_amdgcn_mfma_f32_32x32x16_bf16(a, b, c, 0, 0, 0)
#define EX2(x) __builtin_amdgcn_exp2f(x)
#define LG2(x) __builtin_amdgcn_logf(x)
__device__ __forceinline__ int crow(int r, int hi) { return (r & 3) + 8 * (r >> 2) + 4 * hi; }
__device__ __forceinline__ void load_v_tile(LAS char* vt, const bf16* v0, size_t vstride, int lane) {
    const int c = lane & 7;
#pragma unroll
    for (int i = 0; i < 4; ++i) { const int row = (lane >> 3) + 8 * i; const v4u v = *(const v4u*)(v0 + (size_t)row * vstride + c * 8);
        *(LAS v4u*)(vt + (c >> 2) * 2048 + row * 64 + (c & 3) * 16) = v; }
}
__device__ __forceinline__ void pv_step(f32x16& o0, f32x16& o1, lds_cptr vb, const f32x16& w) {
    v4u pw0, pw1;
    pw0.x = cvtpk(w[0], w[1]); pw0.y = cvtpk(w[2], w[3]); pw0.z = cvtpk(w[4], w[5]); pw0.w = cvtpk(w[6], w[7]);
    pw1.x = cvtpk(w[8], w[9]); pw1.y = cvtpk(w[10], w[11]); pw1.z = cvtpk(w[12], w[13]); pw1.w = cvtpk(w[14], w[15]);
    const bf16x8 p0 = __builtin_bit_cast(bf16x8, pw0), p1 = __builtin_bit_cast(bf16x8, pw1);
    s16x4 lo[4], hh[4];
#pragma unroll
    for (int i = 0; i < 4; ++i) { lo[i] = vtr(vb + (i >> 1) * 2048 + (i & 1) * 1024); hh[i] = vtr(vb + (i >> 1) * 2048 + (i & 1) * 1024 + 512); }
#define VFR(i) (bf16x8){lo[i][0], lo[i][1], lo[i][2], lo[i][3], hh[i][0], hh[i][1], hh[i][2], hh[i][3]}
    o0 = MFMA32(VFR(0), p0, o0); o0 = MFMA32(VFR(1), p1, o0);
    o1 = MFMA32(VFR(2), p0, o1); o1 = MFMA32(VFR(3), p1, o1);
#undef VFR
}
__device__ __forceinline__ void stage_o(LAS char* st, const f32x16& o0, const f32x16& o1, float scale, const float* gain  , int r32, int hi) {
#pragma unroll
    for (int dh = 0; dh < 2; ++dh)
#pragma unroll
        for (int i = 0; i < 4; ++i) { const int d = 32 * dh + 8 * i + 4 * hi; f32x4 g = {1.f, 1.f, 1.f, 1.f}; if (gain) g = *(const f32x4*)(gain + d);
            const f32x16& o = dh ? o1 : o0;
            v2u v; v.x = cvtpk(o[4 * i] * scale * g.x, o[4 * i + 1] * scale * g.y); v.y = cvtpk(o[4 * i + 2] * scale * g.z, o[4 * i + 3] * scale * g.w);
            *(LAS v2u*)(st + r32 * 128 + d * 2) = v; }
}

__device__ __forceinline__ void sb_unit(const bf16* QKV, bf16* O, const float* gsb, int b, int h, int qt, LAS char* wl, int lane) {
    const int r32 = lane & 31, hi = lane >> 5;
    const size_t rowb = (size_t)b * SEQ;
    const bf16* Qp = QKV + (rowb + qt * 32 + r32) * NQKV + h * 64 + hi * 8;
    const bf16* Kb = QKV + rowb * NQKV + 512 + h * 64;
    const bf16* Vb = QKV + rowb * NQKV + 1024 + h * 64;
    bf16x8 qf[4];
#pragma unroll
    for (int d0 = 0; d0 < 4; ++d0) qf[d0] = *(const bf16x8*)(Qp + d0 * 16);
    f32x16 o0 = {}, o1 = {}; float carry = 0.f;
    const lds_cptr vb = (lds_cptr)wl + ((lane >> 4) & 1) * 32 + (lane & 3) * 8 + (4 * hi + ((lane & 15) >> 2)) * 64;
    for (int kt = qt; kt >= 0; --kt) {
        const bf16* kr = Kb + (size_t)(kt * 32 + r32) * NQKV + hi * 8;
        bf16x8 kf[4];
#pragma unroll
        for (int d0 = 0; d0 < 4; ++d0) kf[d0] = *(const bf16x8*)(kr + d0 * 16);
        load_v_tile(wl, Vb + (size_t)(kt * 32) * NQKV, NQKV, lane);
        f32x16 p = {};
#pragma unroll
        for (int d0 = 0; d0 < 4; ++d0) p = MFMA32(kf[d0], qf[d0], p);
        const bool diag = (kt == qt);
        float c[16];
#pragma unroll
        for (int r = 0; r < 16; ++r) { const float z = __builtin_fminf(p[r], 120.f); const bool valid = !diag || (crow(r, hi) < r32);
            const float s = LG2(1.0f + EX2(z)); c[r] = valid ? s : 0.f; p[r] = valid ? z : -1e30f; }
        float Tl[4], Th[4];
#pragma unroll
        for (int i = 0; i < 4; ++i) { c[4 * i + 2] += c[4 * i + 3]; c[4 * i + 1] += c[4 * i + 2]; c[4 * i] += c[4 * i + 1];
            const auto rr = __builtin_amdgcn_permlane32_swap(__float_as_uint(c[4 * i]), __float_as_uint(c[4 * i]), false, false); Tl[i] = __uint_as_float(rr[0]); Th[i] = __uint_as_float(rr[1]); }
        const float U0 = Tl[0] + Th[0], U1 = Tl[1] + Th[1], U2 = Tl[2] + Th[2], U3 = Tl[3] + Th[3];
        float R[4]; R[3] = 0.f; R[2] = U3; R[1] = U3 + U2; R[0] = R[1] + U1; const float total = R[0] + U0;
        f32x16 w;
#pragma unroll
        for (int i = 0; i < 4; ++i) { const float off = carry + R[i] + (hi ? 0.f : Th[i]);
#pragma unroll
            for (int j = 0; j < 4; ++j) w[4 * i + j] = EX2(p[4 * i + j] - (c[4 * i + j] + off)); }
        carry += total;
        pv_step(o0, o1, vb, w);
        if (__all(carry > SB_EXIT_THR)) break;
    }
    float ss = 0.f;
#pragma unroll
    for (int r = 0; r < 16; ++r) ss += o0[r] * o0[r] + o1[r] * o1[r];
    { const auto rr = __builtin_amdgcn_permlane32_swap(__float_as_uint(ss), __float_as_uint(ss), false, false); ss = __uint_as_float(rr[0]) + __uint_as_float(rr[1]); }
    const float rn = __builtin_amdgcn_rsqf(ss * (1.0f / 64.0f) + RMS_EPS);
    LAS char* st = wl + 4096;
    stage_o(st, o0, o1, rn, gsb + h * 64, r32, hi);
#pragma unroll
    for (int i = 0; i < 4; ++i) { const int row = i * 8 + (lane >> 3), ch = lane & 7; const v4u v = *(const LAS v4u*)(st + row * 128 + ch * 16);
        *(v4u*)(O + (rowb + qt * 32 + row) * D + h * 64 + ch * 8) = v; }
}

__device__ __forceinline__ void dil_unit(const bf16* QKV, bf16* PC, float* ML, const float* relb, int b, int h, int cfg, int qt, LAS char* wl, int lane) {
    const int r32 = lane & 31, hi = lane >> 5;
    const int dl = cfg == 0 ? 1 : (cfg == 1 ? 4 : 16), tpr = 64 / dl;
    const int res = qt / tpr, i0 = (qt % tpr) * 32;
    const size_t rowb = (size_t)b * SEQ;
    LAS float* tb = (LAS float*)(wl + 8192);
#pragma unroll
    for (int t = 0; t < 3; ++t) { const int j = lane + 64 * t, step = 159 - j; float v = -1e30f; if (step >= 0 && step <= 128) v = relb[(int)BKT[cfg][step] * 8 + h] * LOG2E; tb[j] = v; }
    const bf16* Qp = QKV + (rowb + (size_t)(i0 + r32) * dl + res) * NQKV + 1536 + h * 64 + hi * 8;
    const bf16* Kb = QKV + (rowb + res) * NQKV + 2048 + h * 64;
    const bf16* Vb = QKV + (rowb + res) * NQKV + 2560 + h * 64;
    const size_t kstride = (size_t)dl * NQKV;
    bf16x8 qf[4];
#pragma unroll
    for (int d0 = 0; d0 < 4; ++d0) qf[d0] = *(const bf16x8*)(Qp + d0 * 16);
    f32x16 o0 = {}, o1 = {}; float m = -1e30f, l = 0.f;
    const lds_cptr vb = (lds_cptr)wl + ((lane >> 4) & 1) * 32 + (lane & 3) * 8 + (4 * hi + ((lane & 15) >> 2)) * 64;
    for (int ik0 = (i0 >= 128 ? i0 - 128 : 0); ik0 <= i0; ik0 += 32) {
        const bf16* kr = Kb + (size_t)(ik0 + r32) * kstride + hi * 8;
        bf16x8 kf[4];
#pragma unroll
        for (int d0 = 0; d0 < 4; ++d0) kf[d0] = *(const bf16x8*)(kr + d0 * 16);
        load_v_tile(wl, Vb + (size_t)ik0 * kstride, kstride, lane);
        f32x16 p = {};
#pragma unroll
        for (int d0 = 0; d0 < 4; ++d0) p = MFMA32(kf[d0], qf[d0], p);
        const int jb = 159 - (i0 - ik0) - r32 + 4 * hi;
        float mt = -1e30f;
#pragma unroll
        for (int r = 0; r < 16; ++r) { p[r] += tb[jb + (r & 3) + 8 * (r >> 2)]; mt = __builtin_fmaxf(mt, p[r]); }
        { const auto rr = __builtin_amdgcn_permlane32_swap(__float_as_uint(mt), __float_as_uint(mt), false, false); mt = __builtin_fmaxf(__uint_as_float(rr[0]), __uint_as_float(rr[1])); }
        const float mn = __builtin_fmaxf(m, mt), alpha = EX2(m - mn); m = mn;
        float ls = 0.f;
#pragma unroll
        for (int r = 0; r < 16; ++r) { p[r] = EX2(p[r] - mn); ls += p[r]; }
        l = l * alpha + ls;
#pragma unroll
        for (int r = 0; r < 16; ++r) { o0[r] *= alpha; o1[r] *= alpha; }
        pv_step(o0, o1, vb, p);
    }
    { const auto rr = __builtin_amdgcn_permlane32_swap(__float_as_uint(l), __float_as_uint(l), false, false); l = __uint_as_float(rr[0]) + __uint_as_float(rr[1]); }
    LAS char* st = wl + 4096;
    stage_o(st, o0, o1, 1.0f, nullptr, r32, hi);
    bf16* pc = PC + (size_t)cfg * M * 512;
#pragma unroll
    for (int i = 0; i < 4; ++i) { const int row = i * 8 + (lane >> 3), ch = lane & 7; const v4u v = *(const LAS v4u*)(st + row * 128 + ch * 16);
        *(v4u*)(pc + (rowb + (size_t)(i0 + row) * dl + res) * 512 + h * 64 + ch * 8) = v; }
    if (hi == 0) { f32x2 ml = {m, l}; *(f32x2*)(ML + (((size_t)cfg * M + rowb + (size_t)(i0 + r32) * dl + res) * 8 + h) * 2) = ml; }
}

struct Args {
    const float *x, *c, *w_ada, *b_ada, *g_ffn1, *w1_gate, *w1_up, *w1_down, *g_mix, *w_in, *g_sb_out, *g_dil_out, *w_out, *rel_bias, *g_ffn2, *w2_gate, *w2_up, *w2_down, *g_final;
    float* out; unsigned char* ws; int ph_lo, ph_hi;
};
__global__ void __launch_bounds__(NWAVES * 64, 2) layer_fwd(Args args) {
    extern __shared__ __attribute__((aligned(16))) unsigned char lds[];
    Frame F;
    F.lds = (LAS unsigned char*)lds;
    F.MISC = (volatile LAS unsigned*)(F.lds + MISC_OFF);
    F.tid = threadIdx.x; F.lane = F.tid & 63; F.wave = __builtin_amdgcn_readfirstlane(F.tid >> 6);
    F.G = gridDim.x; { const int bx = blockIdx.x; F.vcu = (F.G % 8 == 0) ? (bx % 8) * (F.G / 8) + bx / 8 : bx; }
    unsigned char* ws = args.ws;
    F.ctl = (gu32*)(ws + WS_CTL);
    float* const X = args.out;
    float* const rowss = (float*)(ws + WS_ROWSS);
    float* const modv = (float*)(ws + WS_MOD);
    float* const AV = (float*)(ws + WS_VEC); float* const GV = AV + 3 * 16 * 1024;
    float* const bias1 = (float*)(ws + WS_BIAS); float* const bias2 = bias1 + 16 * NGU; float* const bias3 = bias2 + 16 * NQKV;
    float* const rowss1 = (float*)(ws + WS_ROWSS1);
    bf16* const W1GU = (bf16*)(ws + WS_W1GU); bf16* const W1D = (bf16*)(ws + WS_W1D); bf16* const WIN = (bf16*)(ws + WS_WIN); bf16* const WOUT = (bf16*)(ws + WS_WOUT);
    bf16* const W2GU = (bf16*)(ws + WS_W2GU); bf16* const W2D = (bf16*)(ws + WS_W2D);
    bf16* const XA = (bf16*)(ws + WS_XA); bf16* const OB = (bf16*)(ws + WS_O); bf16* const HID = (bf16*)(ws + WS_HID); bf16* const QKV = (bf16*)(ws + WS_QKV);
    bf16* const PC = (bf16*)(ws + WS_PC); float* const ML = (float*)(ws + WS_ML);

    for (int u = F.tid; u < (LDS_BYTES - LDSCTL_OFF) / 4; u += NWAVES * 64) ((LAS unsigned*)(F.lds + LDSCTL_OFF))[u] = 0u;
    __syncthreads();
    XcdBarrier bar; bar.bar = (unsigned*)(F.ctl + CW_BAR); bar.x = 0; bar.st = nullptr;
    if (N_LAUNCHES == 1) bar = xcd_barrier_post((unsigned*)(F.ctl + CW_BAR), F.MISC + 8);
#define GRID_BAR() do { if (N_LAUNCHES == 1) xcd_barrier(bar); } while (0)
    const int lo = args.ph_lo, hi = args.ph_hi;
#define IN(k) (lo <= (k) && (k) < hi)
#define BOTH(k) (IN(k) && IN((k) + 1))
    const int gw = F.vcu * NWAVES + F.wave, NGW = F.G * NWAVES;
    LAS unsigned char* const ring = F.lds + RING_OFF;

    if (IN(0)) {
        for (int un = blockIdx.x; un < NMOD * D / 64; un += F.G)
            gemv16_unit(ring, args.w_ada, NMOD * D, 64 * un, args.c, D, true, modv, NMOD * D, 64 * un, args.b_ada, F.tid, F.wave, F.lane);
        LAS float* scr = (LAS float*)(ring + F.wave * 16384);
        constexpr int NITEMS = 3 * (D / 64) * (FF / 32) * 2 + (D / 64) * (NQKV / 32) + (D / 64) * (D / 32);
        for (int it = gw; it < NITEMS; it += NGW) {
            int r = it;
            if (p0_matrix(r, args.w1_gate, D, FF, W1GU, 1, scr, F.lane)) continue;
            if (p0_matrix(r, args.w1_up, D, FF, W1GU, 2, scr, F.lane)) continue;
            if (p0_matrix(r, args.w1_down, FF, D, W1D, 0, scr, F.lane)) continue;
            if (p0_matrix(r, args.w_in, D, NQKV, WIN, 0, scr, F.lane)) continue;
            if (p0_matrix(r, args.w_out, D, D, WOUT, 0, scr, F.lane)) continue;
            if (p0_matrix(r, args.w2_gate, D, FF, W2GU, 1, scr, F.lane)) continue;
            if (p0_matrix(r, args.w2_up, D, FF, W2GU, 2, scr, F.lane)) continue;
            p0_matrix(r, args.w2_down, FF, D, W2D, 0, scr, F.lane);
        }
        if (BOTH(0)) GRID_BAR();
    }

    if (IN(1)) {
        for (int un = blockIdx.x; un < 224; un += F.G) {
            int r = un;
            if (r < 44) { const int c0 = 64 * r; gemv16_unit(ring, args.w1_gate, FF, c0, modv + 0 * D, NMOD * D, false, bias1, NGU, (c0 >> 7) * 256 + (c0 & 127), nullptr, F.tid, F.wave, F.lane); continue; } r -= 44;
            if (r < 44) { const int c0 = 64 * r; gemv16_unit(ring, args.w1_up, FF, c0, modv + 0 * D, NMOD * D, false, bias1, NGU, (c0 >> 7) * 256 + (c0 & 127) + 128, nullptr, F.tid, F.wave, F.lane); continue; } r -= 44;
            if (r < 48) { const int c0 = 64 * r; gemv16_unit(ring, args.w_in, NQKV, c0, modv + 3 * D, NMOD * D, false, bias2, NQKV, c0, nullptr, F.tid, F.wave, F.lane); continue; } r -= 48;
            if (r < 44) { const int c0 = 64 * r; gemv16_unit(ring, args.w2_gate, FF, c0, modv + 6 * D, NMOD * D, false, bias3, NGU, (c0 >> 7) * 256 + (c0 & 127), nullptr, F.tid, F.wave, F.lane); continue; } r -= 44;
            { const int c0 = 64 * r; gemv16_unit(ring, args.w2_up, FF, c0, modv + 6 * D, NMOD * D, false, bias3, NGU, (c0 >> 7) * 256 + (c0 & 127) + 128, nullptr, F.tid, F.wave, F.lane); }
        }
        for (int i = blockIdx.x * (NWAVES * 64) + F.tid; i < 3 * 16 * 1024; i += F.G * NWAVES * 64) {
            const int s = i >> 14, b = (i >> 10) & 15, k = i & 1023;
            const float* gs = s == 0 ? args.g_ffn1 : (s == 1 ? args.g_mix : args.g_ffn2);
            AV[i] = gs[k] * (1.0f + modv[(size_t)b * NMOD * D + (3 * s + 1) * D + k]);
            GV[i] = modv[(size_t)b * NMOD * D + (3 * s + 2) * D + k] * (s == 1 ? 1.0f : 0.5f);
        }
        for (int m = gw; m < M; m += NGW) {
            const int b = m >> 11;
            const GAS f32x4* xr = (const GAS f32x4*)(args.x + (size_t)m * D) + F.lane;
            const f32x4* g4 = (const f32x4*)args.g_ffn1 + F.lane; const f32x4* s4 = (const f32x4*)(modv + (size_t)b * NMOD * D + 1 * D) + F.lane;
            f32x4 v[4]; float ss = 0.f;
#pragma unroll
            for (int j = 0; j < 4; ++j) { v[j] = xr[64 * j]; ss += (v[j].x * v[j].x + v[j].y * v[j].y) + (v[j].z * v[j].z + v[j].w * v[j].w); }
            ss = wave_sum(ss);
            if (F.lane == 0) rowss1[m] = ss;
            GAS v2u* o8 = (GAS v2u*)(XA + (size_t)m * D) + F.lane;
#pragma unroll
            for (int j = 0; j < 4; ++j) { const f32x4 a = g4[64 * j] * (1.0f + s4[64 * j]); const f32x4 y = v[j] * a; v2u w; w.x = cvtpk(y.x, y.y); w.y = cvtpk(y.z, y.w); o8[64 * j] = w; }
        }
        if (BOTH(1)) GRID_BAR();
    }

    if (IN(2)) {
        pg8::Gemm g{XA, W1GU, M, NGU, D}; pg8::StaticOrder S; S.init(M, NGU, F.G, (int)blockIdx.x);
        pg8::EpiSwiGLU E{HID, rowss1, bias1};
        pg8::gemm_phase<pg8::EpiSwiGLU, pg8::StaticOrder, PG8_ALIGN, PG8_SP2>(ring, g, S, E);
        if (BOTH(2)) GRID_BAR();
    }
    if (IN(3)) {
        pg8::Gemm g{HID, W1D, M, D, FF}; pg8::StaticOrder S; S.init(M, D, F.G, (int)blockIdx.x);
        pg8::EpiResid<true> E{args.x, X, XA, GV + 0 * 16384, AV + 1 * 16384, rowss + 0 * M};
        pg8::gemm_phase<pg8::EpiResid<true>, pg8::StaticOrder, PG8_ALIGN, PG8_SP2>(ring, g, S, E);
        if (BOTH(3)) GRID_BAR();
    }
    if (IN(4)) {
        pg8::Gemm g{XA, WIN, M, NQKV, D}; pg8::StaticOrder S; S.init(M, NQKV, F.G, (int)blockIdx.x);
        pg8::EpiQKV E{QKV, rowss + 0 * M, bias2};
        pg8::gemm_phase<pg8::EpiQKV, pg8::StaticOrder, PG8_ALIGN, PG8_SP2>(ring, g, S, E);
        if (BOTH(4)) GRID_BAR();
    }
    if (IN(5)) {
        LAS char* wl = (LAS char*)(ring + F.wave * 16384);
        constexpr int NSB = BATCH * NH * 64, NDIL = BATCH * NH * 3 * 64;
        for (int un = gw; un < NSB + NDIL; un += NGW) {
            if (un < NSB) { const int qt = un & 63, bh = un >> 6; sb_unit(QKV, OB, args.g_sb_out, bh >> 3, bh & 7, qt, wl, F.lane); }
            else { const int v = un - NSB; const int qt = v & 63, w3 = v >> 6; const int cfg = w3 % 3, bh = w3 / 3; dil_unit(QKV, PC, ML, args.rel_bias, bh >> 3, bh & 7, cfg, qt, wl, F.lane); }
        }
        if (BOTH(5)) GRID_BAR();
    }
    if (IN(6)) {
        const int hh = F.lane >> 3;
        for (int tok = gw; tok < M; tok += NGW) {
            v4u ov[3]; f32x2 ml[3];
#pragma unroll
            for (int cf = 0; cf < 3; ++cf) { ov[cf] = *(const v4u*)(PC + ((size_t)cf * M + tok) * 512 + F.lane * 8); ml[cf] = *(const f32x2*)(ML + (((size_t)cf * M + tok) * 8 + hh) * 2); }
            const float mx = __builtin_fmaxf(__builtin_fmaxf(ml[0].x, ml[1].x), ml[2].x);
            float wgt[3], den = 0.f;
#pragma unroll
            for (int cf = 0; cf < 3; ++cf) { wgt[cf] = EX2(ml[cf].x - mx); den += wgt[cf] * ml[cf].y; }
            const float rden = 1.0f / den;
            float o[8]; float ss = 0.f;
#pragma unroll
            for (int j = 0; j < 8; ++j) { float a = 0.f;
#pragma unroll
                for (int cf = 0; cf < 3; ++cf) { const unsigned wd = ov[cf][j >> 1]; a += wgt[cf] * bf2f((unsigned short)((j & 1) ? (wd >> 16) : (wd & 0xffffu))); }
                o[j] = a * rden; ss += o[j] * o[j]; }
            ss += __shfl_xor(ss, 1); ss += __shfl_xor(ss, 2); ss += __shfl_xor(ss, 4);
            const float rn = __builtin_amdgcn_rsqf(ss * (1.0f / 64.0f) + RMS_EPS);
            const f32x4 g0 = *(const f32x4*)(args.g_dil_out + F.lane * 8), g1 = *(const f32x4*)(args.g_dil_out + F.lane * 8 + 4);
            v4u w; w.x = cvtpk(o[0] * rn * g0.x, o[1] * rn * g0.y); w.y = cvtpk(o[2] * rn * g0.z, o[3] * rn * g0.w); w.z = cvtpk(o[4] * rn * g1.x, o[5] * rn * g1.y); w.w = cvtpk(o[6] * rn * g1.z, o[7] * rn * g1.w);
            *(v4u*)(OB + (size_t)tok * D + 512 + F.lane * 8) = w;
        }
        if (BOTH(6)) GRID_BAR();
    }
    if (IN(7)) {
        pg8::Gemm g{OB, WOUT, M, D, D}; pg8::StaticOrder S; S.init(M, D, F.G, (int)blockIdx.x);
        pg8::EpiResid<true> E{X, X, XA, GV + 1 * 16384, AV + 2 * 16384, rowss + 1 * M};
        pg8::gemm_phase<pg8::EpiResid<true>, pg8::StaticOrder, PG8_ALIGN, PG8_SP2>(ring, g, S, E);
        if (BOTH(7)) GRID_BAR();
    }
    if (IN(8)) {
        pg8::Gemm g{XA, W2GU, M, NGU, D}; pg8::StaticOrder S; S.init(M, NGU, F.G, (int)blockIdx.x);
        pg8::EpiSwiGLU E{HID, rowss + 1 * M, bias3};
        pg8::gemm_phase<pg8::EpiSwiGLU, pg8::StaticOrder, PG8_ALIGN, PG8_SP2>(ring, g, S, E);
        if (BOTH(8)) GRID_BAR();
    }
    if (IN(9)) {
        pg8::Gemm g{HID, W2D, M, D, FF}; pg8::StaticOrder S; S.init(M, D, F.G, (int)blockIdx.x);
        pg8::EpiResid<false> E{X, X, nullptr, GV + 2 * 16384, nullptr, rowss + 2 * M};
        pg8::gemm_phase<pg8::EpiResid<false>, pg8::StaticOrder, PG8_ALIGN, PG8_SP2>(ring, g, S, E);
        if (BOTH(9)) GRID_BAR();
    }
    if (IN(10)) {
        const f32x4* g4 = (const f32x4*)args.g_final + F.lane;
        for (int m = gw; m < M; m += NGW) {
            GAS f32x4* xr = (GAS f32x4*)(X + (size_t)m * D) + F.lane;
            const float rs = __builtin_amdgcn_rsqf(rowss[2 * M + m] * (1.0f / 1024.0f) + RMS_EPS);
#pragma unroll
            for (int j = 0; j < 4; ++j) { const f32x4 v = xr[64 * j]; xr[64 * j] = v * rs * g4[64 * j]; }
        }
    }
#undef IN
#undef BOTH
#undef GRID_BAR
}

extern "C" void kernel_launch(void* const* d_in, const int* in_sizes, int n_in, void* d_out, int out_size, void* d_ws, size_t ws_size, hipStream_t stream) {
    static int grid = 0;
    if (grid == 0) {
        if (n_in != 19 || in_sizes[0] != M * D || out_size != M * D || ws_size < WS_END) { fprintf(stderr, "kernel_launch: built for 19 inputs, x/out of %d floats, >= %zu bytes of workspace; got n_in %d, in0 %d, out %d, ws %zu; nothing launched\n", M * D, (size_t)WS_END, n_in, n_in > 0 ? in_sizes[0] : -1, out_size, ws_size); grid = -1; return; }
        int dev = 0, cus = 0, per_cu = 0;
        if (hipGetDevice(&dev) != hipSuccess || hipDeviceGetAttribute(&cus, hipDeviceAttributeMultiprocessorCount, dev) != hipSuccess) { fprintf(stderr, "kernel_launch: hipGetDevice / hipDeviceGetAttribute failed\n"); grid = -1; return; }
        if (hipFuncSetAttribute((const void*)layer_fwd, hipFuncAttributeMaxDynamicSharedMemorySize, LDS_BYTES) != hipSuccess) { fprintf(stderr, "kernel_launch: hipFuncSetAttribute failed\n"); grid = -1; return; }
        if (hipOccupancyMaxActiveBlocksPerMultiprocessor(&per_cu, (const void*)layer_fwd, NWAVES * 64, LDS_BYTES) != hipSuccess || per_cu < 1)
            fprintf(stderr, "kernel_launch: note: occupancy query reports %d workgroups per CU\n", per_cu);
        (void)hipGetLastError();
        grid = cus;
    }
    if (grid < 0) return;
    if (hipMemsetAsync((char*)d_ws + WS_CTL, 0, CTL_ZERO_BYTES, stream) != hipSuccess) { fprintf(stderr, "kernel_launch: hipMemsetAsync failed\n"); return; }
    Args a{};
    a.x = (const float*)d_in[0]; a.c = (const float*)d_in[1]; a.w_ada = (const float*)d_in[2]; a.b_ada = (const float*)d_in[3]; a.g_ffn1 = (const float*)d_in[4];
    a.w1_gate = (const float*)d_in[5]; a.w1_up = (const float*)d_in[6]; a.w1_down = (const float*)d_in[7]; a.g_mix = (const float*)d_in[8]; a.w_in = (const float*)d_in[9];
    a.g_sb_out = (const float*)d_in[10]; a.g_dil_out = (const float*)d_in[11]; a.w_out = (const float*)d_in[12]; a.rel_bias = (const float*)d_in[13]; a.g_ffn2 = (const float*)d_in[14];
    a.w2_gate = (const float*)d_in[15]; a.w2_up = (const float*)d_in[16]; a.w2_down = (const float*)d_in[17]; a.g_final = (const float*)d_in[18];
    a.out = (float*)d_out; a.ws = (unsigned char*)d_ws;
    for (int li = 0; li < N_LAUNCHES; ++li) {
        a.ph_lo = (N_LAUNCHES == 1) ? 0 : li; a.ph_hi = (N_LAUNCHES == 1) ? N_PHASES : li + 1;
        hipLaunchKernelGGL(layer_fwd, dim3(grid), dim3(NWAVES * 64), LDS_BYTES, stream, a);
        const hipError_t le = hipPeekAtLastError();
        if (le != hipSuccess) { fprintf(stderr, "kernel_launch: launch %d failed: %s\n", li, hipGetErrorName(le)); break; }
    }
}
```

```cpp
#include <hip/hip_runtime.h>
#include <cstdio>
#include <cstdint>
namespace pg8 {
#define PG8_LAS __attribute__((address_space(3)))
typedef unsigned short bf16_t;
typedef short bf16x8 __attribute__((ext_vector_type(8)));
typedef float f32x4 __attribute__((ext_vector_type(4)));
typedef unsigned u32x4 __attribute__((ext_vector_type(4)));
constexpr int BM = 256, BK = 64, HALF = 128, HTB = HALF * BK * 2  , STAGE_BYTES = 8 * HTB, NXCD = 8, WGM = 8;

__host__ __device__ __forceinline__ int lds_byte(int r, int c) { const int st = (r >> 4) * 2 + (c >> 5), rr = r & 15, cc = c & 31, ob = rr * 64 + cc * 2; return st * 1024 + (ob ^ (((ob >> 9) & 1) << 5)); }
__host__ __device__ __forceinline__ void stage_rc(int b, int& R, int& C) { const int st = b / 1024, sb = b % 1024, swz = sb ^ (((sb >> 9) & 1) << 5); R = (st >> 1) * 16 + swz / 64; C = (st & 1) * 32 + (swz % 64) / 2; }
__host__ __device__ __forceinline__ int perm32(int rho) { const int n = rho >> 4, i = rho & 15; return 8 * (i >> 2) + 4 * n + (i & 3); }

struct Unit { int pm, pn; };
struct Gemm { const bf16_t* A; const bf16_t* Bt; int M, N, K; };

struct StaticOrder {
    int nM, nN, nwg, G, c;
    __host__ __device__ void init(int M, int N, int G_, int c_) { nM = M / BM; nN = N / BM; nwg = nM * nN; G = G_; c = c_; }
    __host__ __device__ bool next(int i, Unit& u) const {
        const long L = (long)i * G + c; if (L >= nwg) return false;
        int wgid = (int)L; { const int q = nwg / NXCD, r = nwg % NXCD, xcd = wgid % NXCD, off = wgid / NXCD; wgid = (xcd < r ? xcd * (q + 1) : r * (q + 1) + (xcd - r) * q) + off; }
        const int nig = WGM * nN, gid = wgid / nig, fm = gid * WGM, gsz = (nM - fm) < WGM ? (nM - fm) : WGM;
        u.pm = fm + ((wgid % nig) % gsz); u.pn = (wgid % nig) / gsz; return true;
    }
    __device__ __forceinline__ void a_ready(const Unit&) const {}
    __device__ __forceinline__ void done(const Unit&) const {}
};


typedef float f32x2_t __attribute__((ext_vector_type(2))); typedef __bf16 bf16x2_t __attribute__((ext_vector_type(2)));
typedef unsigned u32x2 __attribute__((ext_vector_type(2)));
__device__ __forceinline__ unsigned cvtpk(float lo, float hi) { f32x2_t v = {lo, hi}; bf16x2_t b = __builtin_convertvector(v, bf16x2_t); return __builtin_bit_cast(unsigned, b); }
constexpr float RMS_EPS = 1e-6f, LOG2E = 1.4426950408889634f;
__device__ __forceinline__ float silu1(float x) { return x * __builtin_amdgcn_rcpf(1.0f + __builtin_amdgcn_exp2f(-LOG2E * x)); }
__device__ __forceinline__ f32x4 silu4(f32x4 v) { f32x4 o; o.x = silu1(v.x); o.y = silu1(v.y); o.z = silu1(v.z); o.w = silu1(v.w); return o; }

struct EpiSwiGLU {
    static constexpr bool PERM = true, AFTER_DRAIN = false;
    bf16_t* H; const float* rowss; const float* bias;
    __device__ __forceinline__ void operator()(const f32x4 (&acc)[2][2][4][2], const Unit& u, int wr, int wc, int fr, int fq) const {
        const int row0 = u.pm * BM + wr * 64 + fr, b = u.pm >> 3;
        const int hc = u.pn * 128 + wc * 32 + 8 * fq;
        const float* bp = bias + (size_t)b * 5632 + u.pn * 256 + wc * 32 + 8 * fq;
        const f32x4 bg0 = *(const f32x4*)(bp), bg1 = *(const f32x4*)(bp + 4), bu0 = *(const f32x4*)(bp + 128), bu1 = *(const f32x4*)(bp + 132);
#pragma unroll
        for (int ai = 0; ai < 2; ++ai)
#pragma unroll
            for (int m = 0; m < 4; ++m) {
                const int r = row0 + ai * HALF + m * 16;
                const float rs = __builtin_amdgcn_rsqf(rowss[r] * (1.0f / 1024.0f) + RMS_EPS);
                const f32x4 g0 = acc[ai][0][m][0] * rs + bg0, g1 = acc[ai][0][m][1] * rs + bg1, u0 = acc[ai][1][m][0] * rs + bu0, u1 = acc[ai][1][m][1] * rs + bu1;
                const f32x4 h0 = silu4(g0) * u0, h1 = silu4(g1) * u1;
                u32x4 w; w.x = cvtpk(h0[0], h0[1]); w.y = cvtpk(h0[2], h0[3]); w.z = cvtpk(h1[0], h1[1]); w.w = cvtpk(h1[2], h1[3]);
                *(u32x4*)(H + (size_t)r * 2816 + hc) = w;
            }
    }
};
struct EpiQKV {
    static constexpr bool PERM = true, AFTER_DRAIN = false;
    bf16_t* O; const float* rowss; const float* bias;
    __device__ __forceinline__ void operator()(const f32x4 (&acc)[2][2][4][2], const Unit& u, int wr, int wc, int fr, int fq) const {
        const int row0 = u.pm * BM + wr * 64 + fr, b = u.pm >> 3;
        const int c0 = u.pn * BM + wc * 32 + 8 * fq;
        const float sc = (u.pn < 2 || u.pn == 6 || u.pn == 7) ? (0.125f * LOG2E) : 1.0f;
        const float* bp = bias + (size_t)b * 3072 + c0;
        f32x4 bv[2][2];
#pragma unroll
        for (int bj = 0; bj < 2; ++bj)
#pragma unroll
            for (int n = 0; n < 2; ++n) bv[bj][n] = *(const f32x4*)(bp + bj * HALF + 4 * n);
#pragma unroll
        for (int ai = 0; ai < 2; ++ai)
#pragma unroll
            for (int m = 0; m < 4; ++m) {
                const int r = row0 + ai * HALF + m * 16;
                const float rs = __builtin_amdgcn_rsqf(rowss[r] * (1.0f / 1024.0f) + RMS_EPS);
                bf16_t* rowp = O + (size_t)r * 3072 + c0;
#pragma unroll
                for (int bj = 0; bj < 2; ++bj) {
                    const f32x4 v0 = (acc[ai][bj][m][0] * rs + bv[bj][0]) * sc, v1 = (acc[ai][bj][m][1] * rs + bv[bj][1]) * sc;
                    u32x4 w; w.x = cvtpk(v0[0], v0[1]); w.y = cvtpk(v0[2], v0[3]); w.z = cvtpk(v1[0], v1[1]); w.w = cvtpk(v1[2], v1[3]);
                    *(u32x4*)(rowp + bj * HALF) = w;
                }
            }
    }
};
template <int MODE> struct EpiResid {
    static constexpr bool PERM = true, AFTER_DRAIN = false;
    const float* basef; bf16_t* y; float* outf; const float* gv; const float* av; const float* ia; float* rowss;
    __device__ __forceinline__ void operator()(const f32x4 (&acc)[2][2][4][2], const Unit& u, int wr, int wc, int fr, int fq) const {
        const int row0 = u.pm * BM + wr * 64 + fr, b = u.pm >> 3;
        const int c0 = u.pn * BM + wc * 32 + 8 * fq;
#pragma unroll
        for (int bj = 0; bj < 2; ++bj) {
            const int c = c0 + bj * HALF; const size_t vo = (size_t)b * 1024 + c;
            const f32x4 g0 = *(const f32x4*)(gv + vo), g1 = *(const f32x4*)(gv + vo + 4);
            f32x4 a0, a1, i0, i1;
            if (MODE != 2) { a0 = *(const f32x4*)(av + vo); a1 = *(const f32x4*)(av + vo + 4); }
            if (MODE != 0) { i0 = *(const f32x4*)(ia + vo); i1 = *(const f32x4*)(ia + vo + 4); }
#pragma unroll
            for (int ai = 0; ai < 2; ++ai)
#pragma unroll
                for (int m = 0; m < 4; ++m) {
                    const int r = row0 + ai * HALF + m * 16; const size_t off = (size_t)r * 1024 + c;
                    f32x4 x0, x1;
                    if (MODE == 0) { x0 = *(const f32x4*)(basef + off); x1 = *(const f32x4*)(basef + off + 4); }
                    else { const u32x4 w = *(const u32x4*)(y + off);
                        x0 = (f32x4){__uint_as_float(w.x << 16), __uint_as_float(w.x & 0xffff0000u), __uint_as_float(w.y << 16), __uint_as_float(w.y & 0xffff0000u)} * i0;
                        x1 = (f32x4){__uint_as_float(w.z << 16), __uint_as_float(w.z & 0xffff0000u), __uint_as_float(w.w << 16), __uint_as_float(w.w & 0xffff0000u)} * i1; }
                    x0 = x0 + g0 * acc[ai][bj][m][0]; x1 = x1 + g1 * acc[ai][bj][m][1];
                    float ss = (x0[0] * x0[0] + x0[1] * x0[1]) + (x0[2] * x0[2] + x0[3] * x0[3]) + (x1[0] * x1[0] + x1[1] * x1[1]) + (x1[2] * x1[2] + x1[3] * x1[3]);
                    if (MODE == 2) { *(f32x4*)(outf + off) = x0; *(f32x4*)(outf + off + 4) = x1; }
                    else { const f32x4 y0 = x0 * a0, y1 = x1 * a1; u32x4 w; w.x = cvtpk(y0[0], y0[1]); w.y = cvtpk(y0[2], y0[3]); w.z = cvtpk(y1[0], y1[1]); w.w = cvtpk(y1[2], y1[3]); *(u32x4*)(y + off) = w; }
                    ss += __shfl_xor(ss, 16); ss += __shfl_xor(ss, 32);
                    if (fq == 0) atomicAdd(rowss + r, ss);
                    if (m & 1) asm volatile("" ::: "memory");
                }
        }
    }
};
template <class Epi, class Sched, bool ALIGN_EPI = false, bool SP2 = false>
__device__ __forceinline__ void gemm_phase(PG8_LAS unsigned char* lds, const Gemm g, const Sched& S, const Epi& E) {
    const int tid = threadIdx.x, wid = __builtin_amdgcn_readfirstlane(tid >> 6), lane = tid & 63, wr = wid >> 2, wc = wid & 3, fr = lane & 15, fq = lane >> 4;
    const int K = g.K, nt = K / BK;
    unsigned voffA[2], voffB[2];
#pragma unroll
    for (int i = 0; i < 2; ++i) { int R, C; stage_rc(tid * 16 + i * 8192, R, C); const int Rb = Epi::PERM ? ((R & ~31) + perm32(R & 31)) : R;
        voffA[i] = (unsigned)(R * K + C) * 2u; voffB[i] = (unsigned)(Rb * K + C) * 2u; }
    const size_t kstep = (size_t)(BK * 2);
    const size_t hstep = (size_t)HALF * K * 2;
    const size_t tstep = 2 * hstep;
    const unsigned ldsw = (unsigned)wid * 1024u;
    const int aoff = lds_byte(wr * 64 + fr, fq * 8), boff = lds_byte(wc * 32 + fr, fq * 8);
#define PG8_SA(b, h) (((b) * 2 + (h)) * HTB)
#define PG8_SB(b, h) ((4 + (b) * 2 + (h)) * HTB)
#define PG8_STAGE(bufoff, gbase, voff) do { _Pragma("unroll") for (int _i = 0; _i < 2; ++_i) \
        __builtin_amdgcn_global_load_lds((const unsigned*)((const char*)(gbase) + (voff)[_i]), (PG8_LAS unsigned*)(lds + (bufoff) + ldsw + _i * 8192), 16, 0, 0); } while (0)
#define PG8_LDA(dst, b, h) do { _Pragma("unroll") for (int m = 0; m < 4; ++m) _Pragma("unroll") for (int k = 0; k < 2; ++k) dst[m][k] = *(const PG8_LAS bf16x8*)(lds + PG8_SA(b, h) + aoff + m * 2048 + k * 1024); } while (0)
#define PG8_LDB(dst, b, h) do { _Pragma("unroll") for (int n = 0; n < 2; ++n) _Pragma("unroll") for (int k = 0; k < 2; ++k) dst[n][k] = *(const PG8_LAS bf16x8*)(lds + PG8_SB(b, h) + boff + n * 2048 + k * 1024); } while (0)
#define PG8_MMA(ai, bj, At, Bt) do { __builtin_amdgcn_s_setprio(1); _Pragma("unroll") for (int m = 0; m < 4; ++m) _Pragma("unroll") for (int n = 0; n < 2; ++n) _Pragma("unroll") for (int k = 0; k < 2; ++k) \
        acc[ai][bj][m][n] = __builtin_amdgcn_mfma_f32_16x16x32_bf16(Bt[n][k], At[m][k], acc[ai][bj][m][n], 0, 0, 0); __builtin_amdgcn_s_setprio(0); } while (0)
#define PG8_WAIT_V(n) asm volatile("s_waitcnt vmcnt(" #n ")" ::: "memory")
#define PG8_WAIT_L(n) asm volatile("s_waitcnt lgkmcnt(" #n ")" ::: "memory")
#define PG8_BAR __builtin_amdgcn_s_barrier()
#define PG8_SCHED __builtin_amdgcn_sched_barrier(0)
    Unit cur, nxt; int ui = 0;
    if (!S.next(0, cur)) return;
    f32x4 acc[2][2][4][2];
#pragma unroll
    for (int a = 0; a < 2; ++a)
#pragma unroll
        for (int b = 0; b < 2; ++b)
#pragma unroll
            for (int m = 0; m < 4; ++m)
#pragma unroll
                for (int n = 0; n < 2; ++n) acc[a][b][m][n] = (f32x4){0.f, 0.f, 0.f, 0.f};
    bf16x8 At[4][2], B0[2][2], B1[2][2];
    const char* cA = (const char*)g.A + (size_t)cur.pm * tstep; const char* cB = (const char*)g.Bt + (size_t)cur.pn * tstep;
    S.a_ready(cur);
    if constexpr (SP2) {
        PG8_STAGE(PG8_SB(0, 0), cB, voffB); PG8_STAGE(PG8_SB(0, 1), cB + hstep, voffB); PG8_STAGE(PG8_SA(0, 0), cA, voffA); PG8_STAGE(PG8_SA(0, 1), cA + hstep, voffA);
        if (wr == 1) PG8_BAR;
        PG8_WAIT_V(2); PG8_BAR;
        PG8_STAGE(PG8_SB(1, 0), cB + kstep, voffB); PG8_STAGE(PG8_SA(1, 0), cA + kstep, voffA); PG8_STAGE(PG8_SB(1, 1), cB + hstep + kstep, voffB);
        PG8_WAIT_V(6); PG8_BAR;
    } else {
        PG8_STAGE(PG8_SB(0, 0), cB, voffB); PG8_STAGE(PG8_SA(0, 0), cA, voffA); PG8_STAGE(PG8_SB(0, 1), cB + hstep, voffB); PG8_STAGE(PG8_SA(0, 1), cA + hstep, voffA);
        if (wr == 1) PG8_BAR;
        PG8_WAIT_V(4); PG8_BAR;
        PG8_STAGE(PG8_SB(1, 0), cB + kstep, voffB); PG8_STAGE(PG8_SA(1, 0), cA + kstep, voffA); PG8_STAGE(PG8_SB(1, 1), cB + hstep + kstep, voffB);
        PG8_WAIT_V(6); PG8_BAR;
    }
    for (;;) {
        const bool has_next = S.next(ui + 1, nxt);
        const char* nA = has_next ? (const char*)g.A + (size_t)nxt.pm * tstep : cA; const char* nB = has_next ? (const char*)g.Bt + (size_t)nxt.pn * tstep : cB;
        for (int t = 0; t < nt; t += 2) {
            const bool last = (t == nt - 2);
            const char* a1 = cA + (size_t)(t + 1) * kstep;
            const char* a2 = last ? nA : cA + (size_t)(t + 2) * kstep; const char* b2 = last ? nB : cB + (size_t)(t + 2) * kstep;
            const char* a3 = a2 + kstep; const char* b3 = b2 + kstep;
            if (last && has_next) S.a_ready(nxt);
            if constexpr (SP2) {
            PG8_LDB(B0, 0, 0); PG8_LDB(B1, 0, 1); PG8_SCHED; PG8_LDA(At, 0, 0); PG8_STAGE(PG8_SA(1, 1), a1 + hstep, voffA);
            PG8_WAIT_V(8); PG8_WAIT_L(0); PG8_BAR; PG8_MMA(0, 0, At, B0); PG8_MMA(0, 1, At, B1); PG8_BAR; PG8_SCHED;
            PG8_LDA(At, 0, 1); PG8_STAGE(PG8_SB(0, 0), b2, voffB); PG8_STAGE(PG8_SB(0, 1), b2 + hstep, voffB); PG8_STAGE(PG8_SA(0, 0), a2, voffA);
            PG8_WAIT_V(8); PG8_WAIT_L(0); PG8_BAR; PG8_MMA(1, 0, At, B0); PG8_MMA(1, 1, At, B1); PG8_BAR; PG8_SCHED;
            PG8_LDB(B0, 1, 0); PG8_LDB(B1, 1, 1); PG8_SCHED; PG8_LDA(At, 1, 0); PG8_STAGE(PG8_SA(0, 1), a2 + hstep, voffA);
            PG8_WAIT_V(8); PG8_WAIT_L(0); PG8_BAR; PG8_MMA(0, 0, At, B0); PG8_MMA(0, 1, At, B1); PG8_BAR; PG8_SCHED;
            PG8_LDA(At, 1, 1); PG8_STAGE(PG8_SB(1, 0), b3, voffB); PG8_STAGE(PG8_SB(1, 1), b3 + hstep, voffB); PG8_STAGE(PG8_SA(1, 0), a3, voffA);
            PG8_WAIT_V(8); PG8_WAIT_L(0); PG8_BAR; PG8_MMA(1, 0, At, B0); PG8_MMA(1, 1, At, B1); PG8_BAR; PG8_SCHED;
            } else {
            PG8_LDB(B0, 0, 0); PG8_SCHED; PG8_LDA(At, 0, 0); PG8_STAGE(PG8_SA(1, 1), a1 + hstep, voffA);
            PG8_WAIT_L(8); PG8_BAR; PG8_WAIT_L(0); PG8_MMA(0, 0, At, B0); PG8_BAR; PG8_SCHED;
            PG8_LDB(B1, 0, 1); PG8_STAGE(PG8_SB(0, 0), b2, voffB);
            PG8_BAR; PG8_WAIT_L(0); PG8_MMA(0, 1, At, B1); PG8_BAR;
            PG8_LDA(At, 0, 1); PG8_STAGE(PG8_SA(0, 0), a2, voffA);
            PG8_BAR; PG8_WAIT_L(0); PG8_MMA(1, 0, At, B0); PG8_BAR; PG8_SCHED;
            PG8_STAGE(PG8_SB(0, 1), b2 + hstep, voffB);
            PG8_WAIT_V(6); PG8_BAR; PG8_MMA(1, 1, At, B1); PG8_BAR;
            PG8_LDB(B0, 1, 0); PG8_SCHED; PG8_LDA(At, 1, 0); PG8_STAGE(PG8_SA(0, 1), a2 + hstep, voffA);
            PG8_WAIT_L(8); PG8_BAR; PG8_WAIT_L(0); PG8_MMA(0, 0, At, B0); PG8_BAR; PG8_SCHED;
            PG8_LDB(B1, 1, 1); PG8_STAGE(PG8_SB(1, 0), b3, voffB);
            PG8_BAR; PG8_WAIT_L(0); PG8_MMA(0, 1, At, B1); PG8_BAR;
            PG8_LDA(At, 1, 1); PG8_STAGE(PG8_SA(1, 0), a3, voffA);
            PG8_BAR; PG8_WAIT_L(0); PG8_MMA(1, 0, At, B0); PG8_BAR; PG8_SCHED;
            PG8_STAGE(PG8_SB(1, 1), b3 + hstep, voffB);
            PG8_WAIT_V(6); PG8_BAR; PG8_MMA(1, 1, At, B1); PG8_BAR;
            }
        }
        if constexpr (ALIGN_EPI) { if (wr == 0) PG8_BAR; }
        if constexpr (!Epi::AFTER_DRAIN) { E(acc, cur, wr, wc, fr, fq); S.done(cur); }
        if (!has_next) break;
#pragma unroll
        for (int a = 0; a < 2; ++a)
#pragma unroll
            for (int b = 0; b < 2; ++b)
#pragma unroll
                for (int m = 0; m < 4; ++m)
#pragma unroll
                    for (int n = 0; n < 2; ++n) acc[a][b][m][n] = (f32x4){0.f, 0.f, 0.f, 0.f};
        cur = nxt; cA = nA; cB = nB; ++ui;
        if constexpr (ALIGN_EPI) { if (wr == 1) PG8_BAR; }
    }
    PG8_WAIT_V(0);
    if constexpr (!ALIGN_EPI) { if (wr == 0) PG8_BAR; }
    PG8_BAR;
    if constexpr (Epi::AFTER_DRAIN) { E.fused(acc, cur, wr, wc, fr, fq, lds, wid, lane); S.done(cur); }
#undef PG8_SA
#undef PG8_SB
#undef PG8_STAGE
#undef PG8_LDA
#undef PG8_LDB
#undef PG8_MMA
#undef PG8_WAIT_V
#undef PG8_WAIT_L
#undef PG8_BAR
#undef PG8_SCHED
}
}

#ifndef PG8_SP2
#define PG8_SP2 true
#endif
#ifndef PG8_ALIGN
#define PG8_ALIGN true
#endif
constexpr int NWAVES = 8;
#ifndef MK_N_LAUNCHES
#define MK_N_LAUNCHES 1
#endif
constexpr int N_PHASES = 11;
constexpr int N_LAUNCHES = MK_N_LAUNCHES;
#ifndef PROBE_DUP
#define PROBE_DUP 0
#endif
#ifndef SB_EXIT_THR
#define SB_EXIT_THR 64.0f
#endif

constexpr int BATCH = 16, SEQ = 2048, D = 1024, FF = 2816, NGU = 2 * FF, NQKV = 3072, NMOD = 9, HD = 64, NH = 8;
constexpr int M = BATCH * SEQ;
constexpr float RMS_EPS = 1e-6f, LOG2E = 1.4426950408889634f;

constexpr size_t MiB = 1u << 20;
constexpr size_t WS_CTL = 0, CTL_ZERO_BYTES = 2 * MiB;
constexpr size_t WS_ROWSS = 1 * MiB;
constexpr size_t WS_MOD = 2 * MiB;
constexpr size_t WS_VEC = 3 * MiB;
constexpr size_t WS_BIAS = 4 * MiB;
constexpr size_t WS_ROWSS1 = 5 * MiB;
constexpr size_t WS_W1GU = 6 * MiB, WS_W1D = 17 * MiB, WS_WIN = 23 * MiB, WS_WOUT = 29 * MiB, WS_W2GU = 31 * MiB, WS_W2D = 42 * MiB;
constexpr size_t WS_XA = 48 * MiB;
constexpr size_t WS_O = 112 * MiB;
constexpr size_t WS_HID = 176 * MiB;
constexpr size_t WS_QKV = 176 * MiB;
constexpr size_t WS_PC = 368 * MiB;
constexpr size_t WS_ML = 464 * MiB;
constexpr size_t WS_END = 470 * MiB;
static_assert(WS_W1GU + (size_t)NGU * D * 2 <= WS_W1D && WS_W1D + (size_t)D * FF * 2 <= WS_WIN && WS_WIN + (size_t)NQKV * D * 2 <= WS_WOUT && WS_WOUT + (size_t)D * D * 2 <= WS_W2GU &&
              WS_W2GU + (size_t)NGU * D * 2 <= WS_W2D && WS_W2D + (size_t)D * FF * 2 <= WS_XA && WS_XA + (size_t)M * D * 2 <= WS_O && WS_O + (size_t)M * D * 2 <= WS_HID &&
              WS_HID + (size_t)M * FF * 2 <= WS_PC && WS_QKV + (size_t)M * NQKV * 2 <= WS_PC && WS_PC + (size_t)3 * M * 512 * 2 <= WS_ML && WS_ML + (size_t)3 * M * 8 * 2 * 4 <= WS_END, "d_ws map");
constexpr int CW_TMO = 0, CW_CODE = 1;
constexpr int CW_BAR = 4096;

constexpr int RING_OFF = 0, RING_BYTES = 131072;
constexpr int LDSCTL_OFF = RING_BYTES, MISC_OFF = LDSCTL_OFF + 320;
constexpr int LDS_BYTES = 147456;
static_assert(MISC_OFF + 128 <= LDS_BYTES, "LDS map");

#define GAS __attribute__((address_space(1)))
#define LAS __attribute__((address_space(3)))
typedef unsigned short bf16;
typedef unsigned v4u __attribute__((ext_vector_type(4)));
typedef unsigned v2u __attribute__((ext_vector_type(2)));
typedef float f32x4 __attribute__((ext_vector_type(4)));
typedef float f32x2 __attribute__((ext_vector_type(2)));
typedef float f32x16 __attribute__((ext_vector_type(16)));
typedef short bf16x8 __attribute__((ext_vector_type(8)));
typedef short s16x4 __attribute__((ext_vector_type(4)));
typedef GAS unsigned gu32;
#define RLX_AGENT __ATOMIC_RELAXED, __HIP_MEMORY_SCOPE_AGENT
#define LDS_WAIT() asm volatile("s_waitcnt lgkmcnt(0)" ::: "memory")
#define VM_WAIT() asm volatile("s_waitcnt vmcnt(0)" ::: "memory")
using pg8::cvtpk;
__device__ __forceinline__ float bf2f(unsigned short h) { return __uint_as_float((unsigned)h << 16); }

#define XB_TMO      128
#define XB_XCNT(j)  (256  + 64 * (j))
#define XB_XSUB(j)  (1280 + 64 * (j))
#define XB_XGEN(j)  (2304 + 64 * (j))
#define XB_TOP      3328
#define XB_TOPGEN   3392
#define XCD_BAR_WORDS 3456
#define XB_SPIN_CAP (1u << 18)

__device__ __forceinline__ unsigned xb_ld(unsigned* p)              { return __hip_atomic_load(p, __ATOMIC_RELAXED, __HIP_MEMORY_SCOPE_AGENT); }
__device__ __forceinline__ unsigned xb_add(unsigned* p, unsigned v) { return __hip_atomic_fetch_add(p, v, __ATOMIC_RELAXED, __HIP_MEMORY_SCOPE_AGENT); }
__device__ __forceinline__ unsigned xb_xcc_id() { return (unsigned)__builtin_amdgcn_s_getreg((3 << 11) | 20) & 0xFu; }
#define XB_SPIN(cond, bar) do { unsigned _sp = 0; while (cond) { __builtin_amdgcn_s_sleep(1); \
    if ((++_sp & 255u) == 0u) { if (xb_ld(&(bar)[XB_TMO])) break; if (_sp > XB_SPIN_CAP) { atomicAdd(&(bar)[XB_TMO], 1u); break; } } } } while (0)

struct XcdBarrier {
    unsigned* bar; unsigned x;
    volatile LAS unsigned* st;
};

__device__ __forceinline__ XcdBarrier xcd_barrier_post(unsigned* bar, volatile LAS unsigned* st) {
    XcdBarrier b; b.bar = bar; b.x = xb_xcc_id(); b.st = st;
    if (threadIdx.x == 0) (void)xb_add(&bar[XB_XCNT(b.x)], 1u);
    return b;
}
__device__ __forceinline__ void xcd_barrier_complete(unsigned* bar, unsigned x, unsigned& nloc, unsigned& nx) {
    const unsigned G = gridDim.x * gridDim.y * gridDim.z;
    unsigned sum, cnt, mine, sp = 0u;
    for (;;) {
        sum = 0u; cnt = 0u; mine = 0u;
#pragma unroll
        for (unsigned j = 0; j < 16; ++j) { const unsigned c = xb_ld(&bar[XB_XCNT(j)]); sum += c; cnt += (c > 0u) ? 1u : 0u; mine = (j == x) ? c : mine; }
        if (sum == G) break;
        __builtin_amdgcn_s_sleep(1);
        if ((++sp & 255u) == 0u) { if (xb_ld(&bar[XB_TMO])) break; if (sp > XB_SPIN_CAP) { atomicAdd(&bar[XB_TMO], 1u); break; } }
    }
    nloc = mine > 0u ? mine : 1u; nx = cnt > 0u ? cnt : 1u;
}

__device__ __forceinline__ void xcd_barrier(const XcdBarrier& b) {
    asm volatile("s_waitcnt vmcnt(0)" ::: "memory");
    __syncthreads();
    if (threadIdx.x == 0) {
        unsigned* bar = b.bar;
        __builtin_amdgcn_s_waitcnt(0);
        unsigned nloc = b.st[0], nx = b.st[1];
        if (nloc == 0u) { xcd_barrier_complete(bar, b.x, nloc, nx); b.st[0] = nloc; b.st[1] = nx; }
        const unsigned old = xb_add(&bar[XB_XSUB(b.x)], 1u);
        const unsigned gen = old / nloc;
        if (old + 1u == (gen + 1u) * nloc) {
            __builtin_amdgcn_fence(__ATOMIC_RELEASE, "agent");
            asm volatile("s_waitcnt vmcnt(0)" ::: "memory");
            const unsigned og = xb_add(&bar[XB_TOP], 1u);
            const unsigned tg = og / nx;
            if (og + 1u == (tg + 1u) * nx) xb_add(&bar[XB_TOPGEN], 1u);
            else XB_SPIN(xb_ld(&bar[XB_TOPGEN]) == tg, bar);
            __builtin_amdgcn_fence(__ATOMIC_ACQUIRE, "agent");
            xb_add(&bar[XB_XGEN(b.x)], 1u);
            asm volatile("s_waitcnt vmcnt(0)" ::: "memory");
        } else {
            XB_SPIN(xb_ld(&bar[XB_XGEN(b.x)]) == gen, bar);
            __builtin_amdgcn_fence(__ATOMIC_ACQUIRE, "agent");
            asm volatile("s_waitcnt vmcnt(0)" ::: "memory");
        }
    }
    __syncthreads();
}

struct Frame {
    LAS unsigned char* lds;
    volatile LAS unsigned* MISC;
    gu32* ctl;
    int tid, lane, wave;
    int vcu, G;
};
__device__ __forceinline__ float wave_sum(float v) {
#pragma unroll
    for (int o = 1; o < 64; o <<= 1) v += __shfl_xor(v, o);
    return v;
}
__device__ const unsigned char BKT[3][132] = {
 {0,1,2,3,4,5,6,7,8,9,10,11,12,13,14,15,16,16,16,16,16,16,17,17,17,17,17,17,17,17,18,18,18,18,18,18,18,18,18,18,19,19,19,19,19,19,19,19,19,19,19,19,19,19,20,20,20,20,20,20,20,20,20,20,20,20,20,20,20,20,20,20,20,21,21,21,21,21,21,21,21,21,21,21,21,21,21,21,21,21,21,21,21,21,21,21,21,21,21,22,22,22,22,22,22,22,22,22,22,22,22,22,22,22,22,22,22,22,22,22,22,22,22,22,22,22,22,22,22,0,0,0},
 {0,4,8,12,16,16,17,17,18,18,19,19,19,19,20,20,20,20,20,21,21,21,21,21,21,22,22,22,22,22,22,22,22,22,23,23,23,23,23,23,23,23,23,23,23,23,24,24,24,24,24,24,24,24,24,24,24,24,24,24,24,24,25,25,25,25,25,25,25,25,25,25,25,25,25,25,25,25,25,25,25,25,25,26,26,26,26,26,26,26,26,26,26,26,26,26,26,26,26,26,26,26,26,26,26,26,26,26,26,26,26,26,26,27,27,27,27,27,27,27,27,27,27,27,27,27,27,27,27,0,0,0},
 {0,16,18,19,20,21,21,22,22,23,23,23,24,24,24,24,25,25,25,25,25,26,26,26,26,26,26,26,26,27,27,27,27,27,27,27,27,27,27,28,28,28,28,28,28,28,28,28,28,28,28,28,29,29,29,29,29,29,29,29,29,29,29,29,29,29,29,29,29,29,30,30,30,30,30,30,30,30,30,30,30,30,30,30,30,30,30,30,30,30,30,30,30,30,30,31,31,31,31,31,31,31,31,31,31,31,31,31,31,31,31,31,31,31,31,31,31,31,31,31,31,31,31,31,31,31,31,31,31,0,0,0}};

__device__ __forceinline__ void p0_transpose_item(const float* W, int K, int N, bf16* WT, int k0, int n0, int drow0, LAS float* scr, int lane) {
#pragma unroll 8
    for (int i = 0; i < 32; ++i) { const int kk = 2 * i + (lane >> 5); scr[kk * 33 + (lane & 31)] = W[(size_t)(k0 + kk) * N + n0 + (lane & 31)]; }
    LDS_WAIT(); asm volatile("" ::: "memory");
    const int c = lane & 7;
#pragma unroll
    for (int j = 0; j < 4; ++j) { const int n = (lane >> 3) + 8 * j; const LAS float* s = scr + (8 * c) * 33 + n;
        v4u o; o.x = cvtpk(s[0 * 33], s[1 * 33]); o.y = cvtpk(s[2 * 33], s[3 * 33]); o.z = cvtpk(s[4 * 33], s[5 * 33]); o.w = cvtpk(s[6 * 33], s[7 * 33]);
        *(GAS v4u*)(WT + (size_t)(drow0 + n) * K + k0 + 8 * c) = o; }
    LDS_WAIT(); asm volatile("" ::: "memory");
}
__device__ __forceinline__ bool p0_matrix(int& r, const float* W, int K, int N, bf16* WT, int GU, LAS float* scr, int lane) {
    const int nblk = N / 32, items = (K / 64) * nblk;
    if (r >= items) { r -= items; return false; }
    const int kb = r / nblk, nb = r % nblk, n0 = 32 * nb;
    const int drow0 = GU == 0 ? n0 : ((n0 >> 7) * 256 + (n0 & 127) + (GU == 2 ? 128 : 0));
    p0_transpose_item(W, K, N, WT, 64 * kb, n0, drow0, scr, lane);
    return true;
}
__device__ __forceinline__ void gemv16_unit(LAS unsigned char* lds, const float* W, int N, int col0, const float* S, int s_stride, bool do_silu, float* out, int out_stride, int oc0, const float* addb,
                                            int tid, int wave, int lane) {
    LAS float* Sl = (LAS float*)lds; LAS float* red = (LAS float*)(lds + 65536);
    for (int i = tid; i < 16 * 256; i += NWAVES * 64) { const int b = i >> 8, k4 = (i & 255) * 4; f32x4 v = *(const f32x4*)(S + (size_t)b * s_stride + k4); if (do_silu) v = pg8::silu4(v); *(LAS f32x4*)(Sl + b * 1024 + k4) = v; }
    __syncthreads();
    float acc[16];
#pragma unroll
    for (int b = 0; b < 16; ++b) acc[b] = 0.f;
    const float* wp = W + (size_t)(wave * 128) * N + col0 + lane;
    for (int k = 0; k < 128; k += 4) {
        const float w0 = wp[(size_t)(k + 0) * N], w1 = wp[(size_t)(k + 1) * N], w2 = wp[(size_t)(k + 2) * N], w3 = wp[(size_t)(k + 3) * N];
#pragma unroll
        for (int b = 0; b < 16; ++b) { const f32x4 s = *(const LAS f32x4*)(Sl + b * 1024 + wave * 128 + k); acc[b] += (s.x * w0 + s.y * w1) + (s.z * w2 + s.w * w3); }
    }
#pragma unroll
    for (int b = 0; b < 16; ++b) red[(wave * 16 + b) * 64 + lane] = acc[b];
    __syncthreads();
#pragma unroll
    for (int j = 0; j < 2; ++j) { const int b = 2 * wave + j; float s = 0.f;
#pragma unroll
        for (int w = 0; w < 8; ++w) s += red[(w * 16 + b) * 64 + lane];
        if (addb) s += addb[col0 + lane];
        out[(size_t)b * out_stride + oc0 + lane] = s; }
    __syncthreads();
}

typedef LAS const char* lds_cptr;
typedef short v4i16_t __attribute__((ext_vector_type(4)));
__device__ __forceinline__ s16x4 vtr(lds_cptr p) { return __builtin_bit_cast(s16x4, __builtin_amdgcn_ds_read_tr16_b64_v4i16((LAS v4i16_t*)p)); }
#define MFMA32(a, b, c) __builtin_amdgcn_mfma_f32_32x32x16_bf16(a, b, c, 0, 0, 0)
#define EX2(x) __builtin_amdgcn_exp2f(x)
#define LG2(x) __builtin_amdgcn_logf(x)
__device__ __forceinline__ int crow(int r, int hi) { return (r & 3) + 8 * (r >> 2) + 4 * hi; }
__device__ __forceinline__ void load_v_tile(LAS char* vt, const bf16* v0, size_t vstride, int lane) {
    const int c = lane & 7;
#pragma unroll
    for (int i = 0; i < 4; ++i) { const int row = (lane >> 3) + 8 * i; const v4u v = *(const v4u*)(v0 + (size_t)row * vstride + c * 8);
        *(LAS v4u*)(vt + (c >> 2) * 2048 + row * 64 + (c & 3) * 16) = v; }
}
__device__ __forceinline__ void pv_step(f32x16& o0, f32x16& o1, lds_cptr vb, const f32x16& w) {
    v4u pw0, pw1;
    pw0.x = cvtpk(w[0], w[1]); pw0.y = cvtpk(w[2], w[3]); pw0.z = cvtpk(w[4], w[5]); pw0.w = cvtpk(w[6], w[7]);
    pw1.x = cvtpk(w[8], w[9]); pw1.y = cvtpk(w[10], w[11]); pw1.z = cvtpk(w[12], w[13]); pw1.w = cvtpk(w[14], w[15]);
    const bf16x8 p0 = __builtin_bit_cast(bf16x8, pw0), p1 = __builtin_bit_cast(bf16x8, pw1);
    s16x4 lo[4], hh[4];
#pragma unroll
    for (int i = 0; i < 4; ++i) { lo[i] = vtr(vb + (i >> 1) * 2048 + (i & 1) * 1024); hh[i] = vtr(vb + (i >> 1) * 2048 + (i & 1) * 1024 + 512); }
#define VFR(i) (bf16x8){lo[i][0], lo[i][1], lo[i][2], lo[i][3], hh[i][0], hh[i][1], hh[i][2], hh[i][3]}
    o0 = MFMA32(VFR(0), p0, o0); o0 = MFMA32(VFR(1), p1, o0);
    o1 = MFMA32(VFR(2), p0, o1); o1 = MFMA32(VFR(3), p1, o1);
#undef VFR
}
__device__ __forceinline__ void stage_o(LAS char* st, const f32x16& o0, const f32x16& o1, float scale, const float* gain  , int r32, int hi) {
#pragma unroll
    for (int dh = 0; dh < 2; ++dh)
#pragma unroll
        for (int i = 0; i < 4; ++i) { const int d = 32 * dh + 8 * i + 4 * hi; f32x4 g = {1.f, 1.f, 1.f, 1.f}; if (gain) g = *(const f32x4*)(gain + d);
            const f32x16& o = dh ? o1 : o0;
            v2u v; v.x = cvtpk(o[4 * i] * scale * g.x, o[4 * i + 1] * scale * g.y); v.y = cvtpk(o[4 * i + 2] * scale * g.z, o[4 * i + 3] * scale * g.w);
            *(LAS v2u*)(st + r32 * 128 + d * 2) = v; }
}

__device__ __forceinline__ void sb_unit(const bf16* QKV, bf16* O, const float* gsb, int b, int h, int qt, LAS char* wl, int lane) {
    const int r32 = lane & 31, hi = lane >> 5;
    const size_t rowb = (size_t)b * SEQ;
    const bf16* Qp = QKV + (rowb + qt * 32 + r32) * NQKV + h * 64 + hi * 8;
    const bf16* Kb = QKV + rowb * NQKV + 512 + h * 64;
    const bf16* Vb = QKV + rowb * NQKV + 1024 + h * 64;
    bf16x8 qf[4];
#pragma unroll
    for (int d0 = 0; d0 < 4; ++d0) qf[d0] = *(const bf16x8*)(Qp + d0 * 16);
    f32x16 o0 = {}, o1 = {}; float carry = 0.f;
    const lds_cptr vb = (lds_cptr)wl + ((lane >> 4) & 1) * 32 + (lane & 3) * 8 + (4 * hi + ((lane & 15) >> 2)) * 64;
    for (int kt = qt; kt >= 0; --kt) {
        const bf16* kr = Kb + (size_t)(kt * 32 + r32) * NQKV + hi * 8;
        bf16x8 kf[4];
#pragma unroll
        for (int d0 = 0; d0 < 4; ++d0) kf[d0] = *(const bf16x8*)(kr + d0 * 16);
        load_v_tile(wl, Vb + (size_t)(kt * 32) * NQKV, NQKV, lane);
        f32x16 p = {};
#pragma unroll
        for (int d0 = 0; d0 < 4; ++d0) p = MFMA32(kf[d0], qf[d0], p);
        const bool diag = (kt == qt);
        float c[16];
#pragma unroll
        for (int r = 0; r < 16; ++r) { const float z = __builtin_fminf(p[r], 120.f); const bool valid = !diag || (crow(r, hi) < r32);
            const float s = LG2(1.0f + EX2(z)); c[r] = valid ? s : 0.f; p[r] = valid ? z : -1e30f; }
        float Tl[4], Th[4];
#pragma unroll
        for (int i = 0; i < 4; ++i) { c[4 * i + 2] += c[4 * i + 3]; c[4 * i + 1] += c[4 * i + 2]; c[4 * i] += c[4 * i + 1];
            const auto rr = __builtin_amdgcn_permlane32_swap(__float_as_uint(c[4 * i]), __float_as_uint(c[4 * i]), false, false); Tl[i] = __uint_as_float(rr[0]); Th[i] = __uint_as_float(rr[1]); }
        const float U0 = Tl[0] + Th[0], U1 = Tl[1] + Th[1], U2 = Tl[2] + Th[2], U3 = Tl[3] + Th[3];
        float R[4]; R[3] = 0.f; R[2] = U3; R[1] = U3 + U2; R[0] = R[1] + U1; const float total = R[0] + U0;
        f32x16 w;
#pragma unroll
        for (int i = 0; i < 4; ++i) { const float off = carry + R[i] + (hi ? 0.f : Th[i]);
#pragma unroll
            for (int j = 0; j < 4; ++j) w[4 * i + j] = EX2(p[4 * i + j] - (c[4 * i + j] + off)); }
        carry += total;
        pv_step(o0, o1, vb, w);
        if (__all(carry > SB_EXIT_THR)) break;
    }
    float ss = 0.f;
#pragma unroll
    for (int r = 0; r < 16; ++r) ss += o0[r] * o0[r] + o1[r] * o1[r];
    { const auto rr = __builtin_amdgcn_permlane32_swap(__float_as_uint(ss), __float_as_uint(ss), false, false); ss = __uint_as_float(rr[0]) + __uint_as_float(rr[1]); }
    const float rn = __builtin_amdgcn_rsqf(ss * (1.0f / 64.0f) + RMS_EPS);
    LAS char* st = wl + 4096;
    stage_o(st, o0, o1, rn, gsb + h * 64, r32, hi);
#pragma unroll
    for (int i = 0; i < 4; ++i) { const int row = i * 8 + (lane >> 3), ch = lane & 7; const v4u v = *(const LAS v4u*)(st + row * 128 + ch * 16);
        *(v4u*)(O + (rowb + qt * 32 + row) * D + h * 64 + ch * 8) = v; }
}

__device__ __forceinline__ void dil_unit(const bf16* QKV, bf16* PC, float* ML, const float* relb, int b, int h, int cfg, int qt, LAS char* wl, int lane) {
    const int r32 = lane & 31, hi = lane >> 5;
    const int dl = cfg == 0 ? 1 : (cfg == 1 ? 4 : 16), tpr = 64 / dl;
    const int res = qt / tpr, i0 = (qt % tpr) * 32;
    const size_t rowb = (size_t)b * SEQ;
    LAS float* tb = (LAS float*)(wl + 8192);
#pragma unroll
    for (int t = 0; t < 3; ++t) { const int j = lane + 64 * t, step = 159 - j; float v = -1e30f; if (step >= 0 && step <= 128) v = relb[(int)BKT[cfg][step] * 8 + h] * LOG2E; tb[j] = v; }
    const bf16* Qp = QKV + (rowb + (size_t)(i0 + r32) * dl + res) * NQKV + 1536 + h * 64 + hi * 8;
    const bf16* Kb = QKV + (rowb + res) * NQKV + 2048 + h * 64;
    const bf16* Vb = QKV + (rowb + res) * NQKV + 2560 + h * 64;
    const size_t kstride = (size_t)dl * NQKV;
    bf16x8 qf[4];
#pragma unroll
    for (int d0 = 0; d0 < 4; ++d0) qf[d0] = *(const bf16x8*)(Qp + d0 * 16);
    f32x16 o0 = {}, o1 = {}; float m = -1e30f, l = 0.f;
    const lds_cptr vb = (lds_cptr)wl + ((lane >> 4) & 1) * 32 + (lane & 3) * 8 + (4 * hi + ((lane & 15) >> 2)) * 64;
    for (int ik0 = (i0 >= 128 ? i0 - 128 : 0); ik0 <= i0; ik0 += 32) {
        const bf16* kr = Kb + (size_t)(ik0 + r32) * kstride + hi * 8;
        bf16x8 kf[4];
#pragma unroll
        for (int d0 = 0; d0 < 4; ++d0) kf[d0] = *(const bf16x8*)(kr + d0 * 16);
        load_v_tile(wl, Vb + (size_t)ik0 * kstride, kstride, lane);
        f32x16 p = {};
#pragma unroll
        for (int d0 = 0; d0 < 4; ++d0) p = MFMA32(kf[d0], qf[d0], p);
        const int jb = 159 - (i0 - ik0) - r32 + 4 * hi;
        float mt = -1e30f;
#pragma unroll
        for (int r = 0; r < 16; ++r) { p[r] += tb[jb + (r & 3) + 8 * (r >> 2)]; mt = __builtin_fmaxf(mt, p[r]); }
        { const auto rr = __builtin_amdgcn_permlane32_swap(__float_as_uint(mt), __float_as_uint(mt), false, false); mt = __builtin_fmaxf(__uint_as_float(rr[0]), __uint_as_float(rr[1])); }
        const float mn = __builtin_fmaxf(m, mt), alpha = EX2(m - mn); m = mn;
        float ls = 0.f;
#pragma unroll
        for (int r = 0; r < 16; ++r) { p[r] = EX2(p[r] - mn); ls += p[r]; }
        l = l * alpha + ls;
#pragma unroll
        for (int r = 0; r < 16; ++r) { o0[r] *= alpha; o1[r] *= alpha; }
        pv_step(o0, o1, vb, p);
    }
    { const auto rr = __builtin_amdgcn_permlane32_swap(__float_as_uint(l), __float_as_uint(l), false, false); l = __uint_as_float(rr[0]) + __uint_as_float(rr[1]); }
    LAS char* st = wl + 4096;
    stage_o(st, o0, o1, 1.0f, nullptr, r32, hi);
    bf16* pc = PC + (size_t)cfg * M * 512;
#pragma unroll
    for (int i = 0; i < 4; ++i) { const int row = i * 8 + (lane >> 3), ch = lane & 7; const v4u v = *(const LAS v4u*)(st + row * 128 + ch * 16);
        *(v4u*)(pc + (rowb + (size_t)(i0 + row) * dl + res) * 512 + h * 64 + ch * 8) = v; }
    if (hi == 0) { f32x2 ml = {m, l}; *(f32x2*)(ML + (((size_t)cfg * M + rowb + (size_t)(i0 + r32) * dl + res) * 8 + h) * 2) = ml; }
}

struct Args {
    const float *x, *c, *w_ada, *b_ada, *g_ffn1, *w1_gate, *w1_up, *w1_down, *g_mix, *w_in, *g_sb_out, *g_dil_out, *w_out, *rel_bias, *g_ffn2, *w2_gate, *w2_up, *w2_down, *g_final;
    float* out; unsigned char* ws; int ph_lo, ph_hi;
};
__global__ void __launch_bounds__(NWAVES * 64, 2) layer_fwd(Args args) {
    extern __shared__ __attribute__((aligned(16))) unsigned char lds[];
    Frame F;
    F.lds = (LAS unsigned char*)lds;
    F.MISC = (volatile LAS unsigned*)(F.lds + MISC_OFF);
    F.tid = threadIdx.x; F.lane = F.tid & 63; F.wave = __builtin_amdgcn_readfirstlane(F.tid >> 6);
    F.G = gridDim.x; { const int bx = blockIdx.x; F.vcu = (F.G % 8 == 0) ? (bx % 8) * (F.G / 8) + bx / 8 : bx; }
    unsigned char* ws = args.ws;
    F.ctl = (gu32*)(ws + WS_CTL);
    float* const X = args.out;
    float* const rowss = (float*)(ws + WS_ROWSS);
    float* const modv = (float*)(ws + WS_MOD);
    float* const AV = (float*)(ws + WS_VEC); float* const GV = AV + 3 * 16 * 1024; float* const IA = GV + 3 * 16 * 1024;
    float* const bias1 = (float*)(ws + WS_BIAS); float* const bias2 = bias1 + 16 * NGU; float* const bias3 = bias2 + 16 * NQKV;
    float* const rowss1 = (float*)(ws + WS_ROWSS1);
    bf16* const W1GU = (bf16*)(ws + WS_W1GU); bf16* const W1D = (bf16*)(ws + WS_W1D); bf16* const WIN = (bf16*)(ws + WS_WIN); bf16* const WOUT = (bf16*)(ws + WS_WOUT);
    bf16* const W2GU = (bf16*)(ws + WS_W2GU); bf16* const W2D = (bf16*)(ws + WS_W2D);
    bf16* const XA = (bf16*)(ws + WS_XA); bf16* const OB = (bf16*)(ws + WS_O); bf16* const HID = (bf16*)(ws + WS_HID); bf16* const QKV = (bf16*)(ws + WS_QKV);
    bf16* const PC = (bf16*)(ws + WS_PC); float* const ML = (float*)(ws + WS_ML);

    for (int u = F.tid; u < (LDS_BYTES - LDSCTL_OFF) / 4; u += NWAVES * 64) ((LAS unsigned*)(F.lds + LDSCTL_OFF))[u] = 0u;
    __syncthreads();
    XcdBarrier bar; bar.bar = (unsigned*)(F.ctl + CW_BAR); bar.x = 0; bar.st = nullptr;
    if (N_LAUNCHES == 1) bar = xcd_barrier_post((unsigned*)(F.ctl + CW_BAR), F.MISC + 8);
#define GRID_BAR() do { if (N_LAUNCHES == 1) xcd_barrier(bar); } while (0)
    const int lo = args.ph_lo, hi = args.ph_hi;
#define IN(k) (lo <= (k) && (k) < hi)
#define BOTH(k) (IN(k) && IN((k) + 1))
    const int gw = F.vcu * NWAVES + F.wave, NGW = F.G * NWAVES;
    LAS unsigned char* const ring = F.lds + RING_OFF;

    if (IN(0)) for (int rep_ = 0; rep_ <= ((PROBE_DUP >> 0) & 1); ++rep_) {
        for (int un = blockIdx.x; un < NMOD * D / 64; un += F.G)
            gemv16_unit(ring, args.w_ada, NMOD * D, 64 * un, args.c, D, true, modv, NMOD * D, 64 * un, args.b_ada, F.tid, F.wave, F.lane);
        LAS float* scr = (LAS float*)(ring + F.wave * 16384);
        constexpr int NITEMS = 3 * (D / 64) * (FF / 32) * 2 + (D / 64) * (NQKV / 32) + (D / 64) * (D / 32);
        for (int it = gw; it < NITEMS; it += NGW) {
            int r = it;
            if (p0_matrix(r, args.w1_gate, D, FF, W1GU, 1, scr, F.lane)) continue;
            if (p0_matrix(r, args.w1_up, D, FF, W1GU, 2, scr, F.lane)) continue;
            if (p0_matrix(r, args.w1_down, FF, D, W1D, 0, scr, F.lane)) continue;
            if (p0_matrix(r, args.w_in, D, NQKV, WIN, 0, scr, F.lane)) continue;
            if (p0_matrix(r, args.w_out, D, D, WOUT, 0, scr, F.lane)) continue;
            if (p0_matrix(r, args.w2_gate, D, FF, W2GU, 1, scr, F.lane)) continue;
            if (p0_matrix(r, args.w2_up, D, FF, W2GU, 2, scr, F.lane)) continue;
            p0_matrix(r, args.w2_down, FF, D, W2D, 0, scr, F.lane);
        }
        if (BOTH(0)) GRID_BAR();
    }

    if (IN(1)) for (int rep_ = 0; rep_ <= ((PROBE_DUP >> 1) & 1); ++rep_) {
        for (int un = blockIdx.x; un < 224; un += F.G) {
            int r = un;
            if (r < 44) { const int c0 = 64 * r; gemv16_unit(ring, args.w1_gate, FF, c0, modv + 0 * D, NMOD * D, false, bias1, NGU, (c0 >> 7) * 256 + (c0 & 127), nullptr, F.tid, F.wave, F.lane); continue; } r -= 44;
            if (r < 44) { const int c0 = 64 * r; gemv16_unit(ring, args.w1_up, FF, c0, modv + 0 * D, NMOD * D, false, bias1, NGU, (c0 >> 7) * 256 + (c0 & 127) + 128, nullptr, F.tid, F.wave, F.lane); continue; } r -= 44;
            if (r < 48) { const int c0 = 64 * r; gemv16_unit(ring, args.w_in, NQKV, c0, modv + 3 * D, NMOD * D, false, bias2, NQKV, c0, nullptr, F.tid, F.wave, F.lane); continue; } r -= 48;
            if (r < 44) { const int c0 = 64 * r; gemv16_unit(ring, args.w2_gate, FF, c0, modv + 6 * D, NMOD * D, false, bias3, NGU, (c0 >> 7) * 256 + (c0 & 127), nullptr, F.tid, F.wave, F.lane); continue; } r -= 44;
            { const int c0 = 64 * r; gemv16_unit(ring, args.w2_up, FF, c0, modv + 6 * D, NMOD * D, false, bias3, NGU, (c0 >> 7) * 256 + (c0 & 127) + 128, nullptr, F.tid, F.wave, F.lane); }
        }
        for (int i = blockIdx.x * (NWAVES * 64) + F.tid; i < 3 * 16 * 1024; i += F.G * NWAVES * 64) {
            const int s = i >> 14, b = (i >> 10) & 15, k = i & 1023;
            const float* gs = s == 0 ? args.g_ffn1 : (s == 1 ? args.g_mix : args.g_ffn2);
            const float av_ = gs[k] * (1.0f + modv[(size_t)b * NMOD * D + (3 * s + 1) * D + k]);
            AV[i] = av_; IA[i] = 1.0f / av_;
            GV[i] = modv[(size_t)b * NMOD * D + (3 * s + 2) * D + k] * (s == 1 ? 1.0f : 0.5f);
        }
        for (int m = gw; m < M; m += NGW) {
            const int b = m >> 11;
            const GAS f32x4* xr = (const GAS f32x4*)(args.x + (size_t)m * D) + F.lane;
            const f32x4* g4 = (const f32x4*)args.g_ffn1 + F.lane; const f32x4* s4 = (const f32x4*)(modv + (size_t)b * NMOD * D + 1 * D) + F.lane;
            f32x4 v[4]; float ss = 0.f;
#pragma unroll
            for (int j = 0; j < 4; ++j) { v[j] = xr[64 * j]; ss += (v[j].x * v[j].x + v[j].y * v[j].y) + (v[j].z * v[j].z + v[j].w * v[j].w); }
            ss = wave_sum(ss);
            if (F.lane == 0) rowss1[m] = ss;
            GAS v2u* o8 = (GAS v2u*)(XA + (size_t)m * D) + F.lane;
#pragma unroll
            for (int j = 0; j < 4; ++j) { const f32x4 a = g4[64 * j] * (1.0f + s4[64 * j]); const f32x4 y = v[j] * a; v2u w; w.x = cvtpk(y.x, y.y); w.y = cvtpk(y.z, y.w); o8[64 * j] = w; }
        }
        if (BOTH(1)) GRID_BAR();
    }

    if (IN(2)) for (int rep_ = 0; rep_ <= ((PROBE_DUP >> 2) & 1); ++rep_) {
        pg8::Gemm g{XA, W1GU, M, NGU, D}; pg8::StaticOrder S; S.init(M, NGU, F.G, (int)blockIdx.x);
        pg8::EpiSwiGLU E{HID, rowss1, bias1};
        pg8::gemm_phase<pg8::EpiSwiGLU, pg8::StaticOrder, PG8_ALIGN, PG8_SP2>(ring, g, S, E);
        if (BOTH(2)) GRID_BAR();
    }
    if (IN(3)) {
        pg8::Gemm g{HID, W1D, M, D, FF}; pg8::StaticOrder S; S.init(M, D, F.G, (int)blockIdx.x);
        pg8::EpiResid<0> E{args.x, XA, nullptr, GV + 0 * 16384, AV + 1 * 16384, nullptr, rowss + 0 * M};
        pg8::gemm_phase<pg8::EpiResid<0>, pg8::StaticOrder, PG8_ALIGN, PG8_SP2>(ring, g, S, E);
        if (BOTH(3)) GRID_BAR();
    }
    if (IN(4)) for (int rep_ = 0; rep_ <= ((PROBE_DUP >> 4) & 1); ++rep_) {
        pg8::Gemm g{XA, WIN, M, NQKV, D}; pg8::StaticOrder S; S.init(M, NQKV, F.G, (int)blockIdx.x);
        pg8::EpiQKV E{QKV, rowss + 0 * M, bias2};
        pg8::gemm_phase<pg8::EpiQKV, pg8::StaticOrder, PG8_ALIGN, PG8_SP2>(ring, g, S, E);
        if (BOTH(4)) GRID_BAR();
    }
    if (IN(5)) for (int rep_ = 0; rep_ <= ((PROBE_DUP >> 5) & 1); ++rep_) {
        LAS char* wl = (LAS char*)(ring + F.wave * 16384);
        constexpr int NSB = BATCH * NH * 64, NDIL = BATCH * NH * 3 * 64;
        for (int un = gw; un < NSB + NDIL; un += NGW) {
            if (un < NSB) { const int qt = un & 63, bh = un >> 6; sb_unit(QKV, OB, args.g_sb_out, bh >> 3, bh & 7, qt, wl, F.lane); }
            else { const int v = un - NSB; const int qt = v & 63, w3 = v >> 6; const int cfg = w3 % 3, bh = w3 / 3; dil_unit(QKV, PC, ML, args.rel_bias, bh >> 3, bh & 7, cfg, qt, wl, F.lane); }
        }
        if (BOTH(5)) GRID_BAR();
    }
    if (IN(6)) for (int rep_ = 0; rep_ <= ((PROBE_DUP >> 6) & 1); ++rep_) {
        const int hh = F.lane >> 3;
        for (int tok = gw; tok < M; tok += NGW) {
            v4u ov[3]; f32x2 ml[3];
#pragma unroll
            for (int cf = 0; cf < 3; ++cf) { ov[cf] = *(const v4u*)(PC + ((size_t)cf * M + tok) * 512 + F.lane * 8); ml[cf] = *(const f32x2*)(ML + (((size_t)cf * M + tok) * 8 + hh) * 2); }
            const float mx = __builtin_fmaxf(__builtin_fmaxf(ml[0].x, ml[1].x), ml[2].x);
            float wgt[3], den = 0.f;
#pragma unroll
            for (int cf = 0; cf < 3; ++cf) { wgt[cf] = EX2(ml[cf].x - mx); den += wgt[cf] * ml[cf].y; }
            const float rden = 1.0f / den;
            float o[8]; float ss = 0.f;
#pragma unroll
            for (int j = 0; j < 8; ++j) { float a = 0.f;
#pragma unroll
                for (int cf = 0; cf < 3; ++cf) { const unsigned wd = ov[cf][j >> 1]; a += wgt[cf] * bf2f((unsigned short)((j & 1) ? (wd >> 16) : (wd & 0xffffu))); }
                o[j] = a * rden; ss += o[j] * o[j]; }
            ss += __shfl_xor(ss, 1); ss += __shfl_xor(ss, 2); ss += __shfl_xor(ss, 4);
            const float rn = __builtin_amdgcn_rsqf(ss * (1.0f / 64.0f) + RMS_EPS);
            const f32x4 g0 = *(const f32x4*)(args.g_dil_out + F.lane * 8), g1 = *(const f32x4*)(args.g_dil_out + F.lane * 8 + 4);
            v4u w; w.x = cvtpk(o[0] * rn * g0.x, o[1] * rn * g0.y); w.y = cvtpk(o[2] * rn * g0.z, o[3] * rn * g0.w); w.z = cvtpk(o[4] * rn * g1.x, o[5] * rn * g1.y); w.w = cvtpk(o[6] * rn * g1.z, o[7] * rn * g1.w);
            *(v4u*)(OB + (size_t)tok * D + 512 + F.lane * 8) = w;
        }
        if (BOTH(6)) GRID_BAR();
    }
    if (IN(7)) {
        pg8::Gemm g{OB, WOUT, M, D, D}; pg8::StaticOrder S; S.init(M, D, F.G, (int)blockIdx.x);
        pg8::EpiResid<1> E{nullptr, XA, nullptr, GV + 1 * 16384, AV + 2 * 16384, IA + 1 * 16384, rowss + 1 * M};
        pg8::gemm_phase<pg8::EpiResid<1>, pg8::StaticOrder, PG8_ALIGN, PG8_SP2>(ring, g, S, E);
        if (BOTH(7)) GRID_BAR();
    }
    if (IN(8)) for (int rep_ = 0; rep_ <= ((PROBE_DUP >> 8) & 1); ++rep_) {
        pg8::Gemm g{XA, W2GU, M, NGU, D}; pg8::StaticOrder S; S.init(M, NGU, F.G, (int)blockIdx.x);
        pg8::EpiSwiGLU E{HID, rowss + 1 * M, bias3};
        pg8::gemm_phase<pg8::EpiSwiGLU, pg8::StaticOrder, PG8_ALIGN, PG8_SP2>(ring, g, S, E);
        if (BOTH(8)) GRID_BAR();
    }
    if (IN(9)) {
        pg8::Gemm g{HID, W2D, M, D, FF}; pg8::StaticOrder S; S.init(M, D, F.G, (int)blockIdx.x);
        pg8::EpiResid<2> E{nullptr, XA, X, GV + 2 * 16384, nullptr, IA + 2 * 16384, rowss + 2 * M};
        pg8::gemm_phase<pg8::EpiResid<2>, pg8::StaticOrder, PG8_ALIGN, PG8_SP2>(ring, g, S, E);
        if (BOTH(9)) GRID_BAR();
    }
    if (IN(10)) {
        const f32x4* g4 = (const f32x4*)args.g_final + F.lane;
        for (int m = gw; m < M; m += NGW) {
            GAS f32x4* xr = (GAS f32x4*)(X + (size_t)m * D) + F.lane;
            const float rs = __builtin_amdgcn_rsqf(rowss[2 * M + m] * (1.0f / 1024.0f) + RMS_EPS);
#pragma unroll
            for (int j = 0; j < 4; ++j) { const f32x4 v = xr[64 * j]; xr[64 * j] = v * rs * g4[64 * j]; }
        }
    }
#undef IN
#undef BOTH
#undef GRID_BAR
}

extern "C" void kernel_launch(void* const* d_in, const int* in_sizes, int n_in, void* d_out, int out_size, void* d_ws, size_t ws_size, hipStream_t stream) {
    static int grid = 0;
    if (grid == 0) {
        if (n_in != 19 || in_sizes[0] != M * D || out_size != M * D || ws_size < WS_END) { fprintf(stderr, "kernel_launch: built for 19 inputs, x/out of %d floats, >= %zu bytes of workspace; got n_in %d, in0 %d, out %d, ws %zu; nothing launched\n", M * D, (size_t)WS_END, n_in, n_in > 0 ? in_sizes[0] : -1, out_size, ws_size); grid = -1; return; }
        int dev = 0, cus = 0, per_cu = 0;
        if (hipGetDevice(&dev) != hipSuccess || hipDeviceGetAttribute(&cus, hipDeviceAttributeMultiprocessorCount, dev) != hipSuccess) { fprintf(stderr, "kernel_launch: hipGetDevice / hipDeviceGetAttribute failed\n"); grid = -1; return; }
        if (hipFuncSetAttribute((const void*)layer_fwd, hipFuncAttributeMaxDynamicSharedMemorySize, LDS_BYTES) != hipSuccess) { fprintf(stderr, "kernel_launch: hipFuncSetAttribute failed\n"); grid = -1; return; }
        if (hipOccupancyMaxActiveBlocksPerMultiprocessor(&per_cu, (const void*)layer_fwd, NWAVES * 64, LDS_BYTES) != hipSuccess || per_cu < 1)
            fprintf(stderr, "kernel_launch: note: occupancy query reports %d workgroups per CU\n", per_cu);
        (void)hipGetLastError();
        grid = cus;
    }
    if (grid < 0) return;
    if (hipMemsetAsync((char*)d_ws + WS_CTL, 0, CTL_ZERO_BYTES, stream) != hipSuccess) { fprintf(stderr, "kernel_launch: hipMemsetAsync failed\n"); return; }
    Args a{};
    a.x = (const float*)d_in[0]; a.c = (const float*)d_in[1]; a.w_ada = (const float*)d_in[2]; a.b_ada = (const float*)d_in[3]; a.g_ffn1 = (const float*)d_in[4];
    a.w1_gate = (const float*)d_in[5]; a.w1_up = (const float*)d_in[6]; a.w1_down = (const float*)d_in[7]; a.g_mix = (const float*)d_in[8]; a.w_in = (const float*)d_in[9];
    a.g_sb_out = (const float*)d_in[10]; a.g_dil_out = (const float*)d_in[11]; a.w_out = (const float*)d_in[12]; a.rel_bias = (const float*)d_in[13]; a.g_ffn2 = (const float*)d_in[14];
    a.w2_gate = (const float*)d_in[15]; a.w2_up = (const float*)d_in[16]; a.w2_down = (const float*)d_in[17]; a.g_final = (const float*)d_in[18];
    a.out = (float*)d_out; a.ws = (unsigned char*)d_ws;
    for (int li = 0; li < N_LAUNCHES; ++li) {
        a.ph_lo = (N_LAUNCHES == 1) ? 0 : li; a.ph_hi = (N_LAUNCHES == 1) ? N_PHASES : li + 1;
        hipLaunchKernelGGL(layer_fwd, dim3(grid), dim3(NWAVES * 64), LDS_BYTES, stream, a);
        const hipError_t le = hipPeekAtLastError();
        if (le != hipSuccess) { fprintf(stderr, "kernel_launch: launch %d failed: %s\n", li, hipGetErrorName(le)); break; }
    }
}
```
